# Optimizing an MI355X kernel written in HIP

```python
import math
import jax, jax.numpy as jnp
from jax import lax
import numpy as np

D_MODEL = 1024
BATCH = 8
SEQ = 8192
DEPTH = 1

MEM_LEN = 256
SSD_HEAD_DIM = 64
SSD_WIDTH = D_MODEL // 2
SSD_HEADS = SSD_WIDTH // SSD_HEAD_DIM
SSD_GROUPS = 2
SSD_HEADS_PER_GROUP = SSD_HEADS // SSD_GROUPS
SSD_STATE = 64
SSD_CONV = 4
SSD_CHUNK = 128
SC_WIDTH = D_MODEL - SSD_WIDTH
SC_CONV = 3
MIX_WIDTH = SSD_WIDTH + SC_WIDTH
XBC_WIDTH = SSD_WIDTH + 2 * SSD_GROUPS * SSD_STATE
IN_COLS = SSD_WIDTH + XBC_WIDTH + SSD_HEADS + 3 * SC_WIDTH
XA_HEADS = 4
XA_HEAD_DIM = D_MODEL // XA_HEADS
N_GROUPS_MOE = 4
EXPERTS_PER_GROUP = 8
N_EXPERTS = N_GROUPS_MOE * EXPERTS_PER_GROUP
TOP_K = 2
D_EXPERT = D_MODEL // 2
MOE_BLOCK = 128
EPS = 1e-6

kernel_name = 'hybrid_ssd_shortconv_memxattn_hmoe'


def rms_norm(x, g):
    xf = x.astype(jnp.float32)
    y = xf * lax.rsqrt(jnp.mean(xf * xf, axis=-1, keepdims=True) + EPS)
    return (y * g.astype(jnp.float32)).astype(x.dtype)


def causal_dwconv(u, w):
    k = w.shape[0]
    s = u.shape[1]
    up = jnp.pad(u, ((0, 0), (k - 1, 0), (0, 0)))
    out = up[:, 0:s] * w[0]
    for i in range(1, k):
        out = out + up[:, i:i + s] * w[i]
    return out


def ssd_chunked(x, dt, a, bm, cm):
    f32 = jnp.float32
    bsz, s, _ = x.shape
    nc = s // SSD_CHUNK
    G, R, P, N, Q = SSD_GROUPS, SSD_HEADS_PER_GROUP, SSD_HEAD_DIM, SSD_STATE, SSD_CHUNK
    xc = x.astype(f32).reshape(bsz, nc, Q, G, R, P)
    dtc = dt.astype(f32).reshape(bsz, nc, Q, G, R)
    bc = bm.astype(f32).reshape(bsz, nc, Q, G, N)
    cc = cm.astype(f32).reshape(bsz, nc, Q, G, N)
    a_dt = (dtc * a.astype(f32).reshape(G, R)).transpose(0, 3, 4, 1, 2)
    cs = jnp.cumsum(a_dt, axis=-1)
    xdt = xc * dtc[..., None]
    causal = jnp.tril(jnp.ones((Q, Q), dtype=bool))
    decay = jnp.exp(jnp.where(causal, cs[..., :, None] - cs[..., None, :], -jnp.inf))
    cb = jnp.einsum('bclgn,bcsgn->bgcls', cc, bc)
    y_diag = jnp.einsum('bgcls,bgrcls,bcsgrp->bclgrp', cb, decay, xdt)
    decay_in = jnp.exp(cs[..., -1:] - cs)
    states = jnp.einsum('bclgn,bgrcl,bclgrp->bcgrpn', bc, decay_in, xdt)
    chunk_decay = jnp.exp(cs[..., -1])

    def step(carry, inp):
        st, dec = inp
        return carry * dec[..., None, None] + st, carry

    init = jnp.zeros((bsz, G, R, P, N), states.dtype)
    _, prev = lax.scan(step, init, (states.transpose(1, 0, 2, 3, 4, 5), chunk_decay.transpose(3, 0, 1, 2)))
    prev = prev.transpose(1, 0, 2, 3, 4, 5)
    y_off = jnp.einsum('bclgn,bcgrpn,bgrcl->bclgrp', cc, prev, jnp.exp(cs))
    return (y_diag + y_off).reshape(bsz, s, G * R * P).astype(x.dtype)


def hybrid_mixer(n, w_in, conv_ssd_w, conv_ssd_b, dt_bias, a_log, d_skip, norm_ssd_gate, conv_short_w, w_out):
    proj = n @ w_in
    o1 = SSD_WIDTH
    o2 = o1 + XBC_WIDTH
    o3 = o2 + SSD_HEADS
    o4 = o3 + SC_WIDTH
    o5 = o4 + SC_WIDTH
    z, xbc, dt_raw, g_b, g_c, v = jnp.split(proj, [o1, o2, o3, o4, o5], axis=-1)
    xbc = jax.nn.silu(causal_dwconv(xbc, conv_ssd_w) + conv_ssd_b)
    xs, bm, cm = jnp.split(xbc, [SSD_WIDTH, SSD_WIDTH + SSD_GROUPS * SSD_STATE], axis=-1)
    dt = jax.nn.softplus(dt_raw + dt_bias)
    a = -jnp.exp(a_log)
    y = ssd_chunked(xs, dt, a, bm, cm) + xs * jnp.repeat(d_skip, SSD_HEAD_DIM)
    gated = (y * jax.nn.silu(z)).reshape(y.shape[:-1] + (SSD_GROUPS, SSD_WIDTH // SSD_GROUPS))
    y_ssd = rms_norm(gated, norm_ssd_gate.reshape(SSD_GROUPS, SSD_WIDTH // SSD_GROUPS)).reshape(y.shape)
    y_sc = g_b * causal_dwconv(g_c * v, conv_short_w)
    return jnp.concatenate([y_ssd, y_sc], axis=-1) @ w_out


def memory_cross_attention(n, mem_n, w_q, w_kv, w_o):
    bsz, s, d = n.shape
    m = mem_n.shape[1]
    q = (n @ w_q).reshape(bsz, s, XA_HEADS, XA_HEAD_DIM)
    k, v = jnp.split(mem_n @ w_kv, 2, axis=-1)
    k = k.reshape(bsz, m, XA_HEADS, XA_HEAD_DIM)
    v = v.reshape(bsz, m, XA_HEADS, XA_HEAD_DIM)
    scores = jnp.einsum('bshd,bmhd->bhsm', q, k).astype(jnp.float32) * (XA_HEAD_DIM ** -0.5)
    p = jax.nn.softmax(scores, axis=-1).astype(v.dtype)
    o = jnp.einsum('bhsm,bmhd->bshd', p, v).reshape(bsz, s, d)
    return o @ w_o


def hierarchical_moe(n, w_rg, b_rg, w_re, b_re, w_gate, w_up, w_down):
    bsz, s, d = n.shape
    t = n.reshape(-1, d)
    T = t.shape[0]
    f32 = jnp.float32
    g_prob = jax.nn.softmax((t @ w_rg).astype(f32) + b_rg.astype(f32), axis=-1)
    g_idx = jnp.argmax(g_prob, axis=-1).astype(jnp.int32)
    g_w = jnp.take_along_axis(g_prob, g_idx[:, None], axis=-1)
    e_logits = ((t @ w_re).astype(f32) + b_re.astype(f32)).reshape(T, N_GROUPS_MOE, EXPERTS_PER_GROUP)
    e_logits = jnp.take_along_axis(e_logits, g_idx[:, None, None], axis=1)[:, 0]
    e_prob = jax.nn.softmax(e_logits, axis=-1)
    top_w, top_i = lax.top_k(e_prob, TOP_K)
    top_w = top_w / jnp.sum(top_w, axis=-1, keepdims=True)
    comb = (g_w * top_w).reshape(-1)
    flat_e = (g_idx[:, None] * EXPERTS_PER_GROUP + top_i.astype(jnp.int32)).reshape(-1)
    n_assign = T * TOP_K
    n_blocks = (n_assign + MOE_BLOCK - 1) // MOE_BLOCK + N_EXPERTS
    order = jnp.argsort(flat_e)
    tok_of = order // TOP_K
    sorted_e = flat_e[order]
    sizes = jnp.bincount(flat_e, length=N_EXPERTS)
    padded = ((sizes + MOE_BLOCK - 1) // MOE_BLOCK) * MOE_BLOCK
    pad_end = jnp.cumsum(padded)
    pad_start = pad_end - padded
    seg_start = jnp.cumsum(sizes) - sizes
    dest = pad_start[sorted_e] + (jnp.arange(n_assign) - seg_start[sorted_e])
    buf = jnp.zeros((n_blocks * MOE_BLOCK, d), t.dtype).at[dest].set(t[tok_of])
    block_expert = jnp.clip(jnp.searchsorted(pad_end, jnp.arange(n_blocks) * MOE_BLOCK, side='right'), 0, N_EXPERTS - 1)

    def expert_block(args):
        xb, e = args
        return (jax.nn.silu(xb @ w_gate[e]) * (xb @ w_up[e])) @ w_down[e]

    y_buf = lax.map(expert_block, (buf.reshape(n_blocks, MOE_BLOCK, d), block_expert))
    y_sorted = y_buf.reshape(-1, d)[dest] * comb[order][:, None].astype(t.dtype)
    out = jnp.zeros_like(t).at[tok_of].add(y_sorted)
    return out.reshape(bsz, s, d)


def setup_inputs(seed: int = 0) -> dict:
    key = jax.random.key(seed)
    ks = jax.random.split(key, 26)
    L, D = DEPTH, D_MODEL

    def nrm(k, shape, scale):
        return jax.random.normal(k, shape, jnp.float32) * scale

    def gain(k, shape):
        return 1.0 + 0.02 * jax.random.normal(k, shape, jnp.float32)

    dt0 = jnp.exp(jax.random.uniform(ks[7], (L, SSD_HEADS), jnp.float32, minval=math.log(1e-3), maxval=math.log(1e-1)))
    return {
        'x': nrm(ks[0], (BATCH, SEQ, D), 1.0),
        'mem': nrm(ks[1], (BATCH, MEM_LEN, D), 1.0),
        'norm_mem': gain(ks[2], (D,)),
        'norm_mix': gain(ks[3], (L, D)),
        'w_in': nrm(ks[4], (L, D, IN_COLS), D ** -0.5),
        'conv_ssd_w': nrm(ks[5], (L, SSD_CONV, XBC_WIDTH), SSD_CONV ** -0.5),
        'conv_ssd_b': nrm(ks[6], (L, XBC_WIDTH), 0.02),
        'dt_bias': dt0 + jnp.log(-jnp.expm1(-dt0)),
        'a_log': jnp.log(jax.random.uniform(ks[8], (L, SSD_HEADS), jnp.float32, minval=1.0, maxval=16.0)),
        'd_skip': 1.0 + 0.1 * jax.random.normal(ks[9], (L, SSD_HEADS), jnp.float32),
        'norm_ssd_gate': gain(ks[10], (L, SSD_WIDTH)),
        'conv_short_w': nrm(ks[11], (L, SC_CONV, SC_WIDTH), SC_CONV ** -0.5),
        'w_out': nrm(ks[12], (L, MIX_WIDTH, D), MIX_WIDTH ** -0.5),
        'norm_xattn': gain(ks[13], (L, D)),
        'w_q': nrm(ks[14], (L, D, D), D ** -0.5),
        'w_kv': nrm(ks[15], (L, D, 2 * D), D ** -0.5),
        'w_o': nrm(ks[16], (L, D, D), D ** -0.5),
        'norm_moe': gain(ks[17], (L, D)),
        'w_router_group': nrm(ks[18], (L, D, N_GROUPS_MOE), D ** -0.5),
        'b_router_group': nrm(ks[19], (L, N_GROUPS_MOE), 0.01),
        'w_router_expert': nrm(ks[20], (L, D, N_EXPERTS), D ** -0.5),
        'b_router_expert': nrm(ks[21], (L, N_EXPERTS), 0.01),
        'w_gate': nrm(ks[22], (L, N_EXPERTS, D, D_EXPERT), D ** -0.5),
        'w_up': nrm(ks[23], (L, N_EXPERTS, D, D_EXPERT), D ** -0.5),
        'w_down': nrm(ks[24], (L, N_EXPERTS, D_EXPERT, D), D_EXPERT ** -0.5),
        'norm_final': gain(ks[25], (D,)),
    }


def reference(x, mem, norm_mem, norm_mix, w_in, conv_ssd_w, conv_ssd_b, dt_bias, a_log, d_skip,
              norm_ssd_gate, conv_short_w, w_out, norm_xattn, w_q, w_kv, w_o, norm_moe,
              w_router_group, b_router_group, w_router_expert, b_router_expert,
              w_gate, w_up, w_down, norm_final):
    mem_n = rms_norm(mem, norm_mem)
    h = x
    for l in range(DEPTH):
        h = h + hybrid_mixer(rms_norm(h, norm_mix[l]), w_in[l], conv_ssd_w[l], conv_ssd_b[l],
                             dt_bias[l], a_log[l], d_skip[l], norm_ssd_gate[l], conv_short_w[l], w_out[l])
        h = h + memory_cross_attention(rms_norm(h, norm_xattn[l]), mem_n, w_q[l], w_kv[l], w_o[l])
        h = h + hierarchical_moe(rms_norm(h, norm_moe[l]), w_router_group[l], b_router_group[l],
                                 w_router_expert[l], b_router_expert[l], w_gate[l], w_up[l], w_down[l])
    return rms_norm(h, norm_final)
```

```cpp
#include <hip/hip_runtime.h>
#ifndef MOE_GU_F8
#define MOE_GU_F8 1
#endif
#ifndef MOE_DN_F8
#define MOE_DN_F8 1
#endif
#ifndef ATT_O_F8
#define ATT_O_F8 1
#endif
#ifndef ATT_S_F8
#define ATT_S_F8 1
#endif
#ifndef PROBE_DUP
#define PROBE_DUP -1
#endif
#include <cstdio>
#include <cstdint>

#define LAS __attribute__((address_space(3)))
typedef unsigned short bf16_t;
typedef short bf16x8 __attribute__((ext_vector_type(8)));
typedef float f32x4 __attribute__((ext_vector_type(4)));
typedef float f32x2 __attribute__((ext_vector_type(2)));
typedef unsigned u32x4 __attribute__((ext_vector_type(4)));
typedef unsigned u32x2 __attribute__((ext_vector_type(2)));
typedef int v8i __attribute__((ext_vector_type(8)));

constexpr int T = 65536, D = 1024, SEQ = 8192, NBATCH = 8, MEMLEN = 256, NMEM = NBATCH * MEMLEN;
constexpr int NPROJ = 2816;
constexpr int PC_Z = 0, PC_XS = 512, PC_B = 1024, PC_C = 1152, PC_GB = 1280, PC_GC = 1792, PC_V = 2304;
constexpr int INCOLS = 2824;
constexpr int NEXP = 32, DEXP = 512;
constexpr float EPS = 1e-6f;
constexpr float LOG2E = 1.4426950408889634f;

constexpr size_t MiB = 1u << 20;
constexpr size_t WS_CTL = 0, CTL_BYTES = 1 * MiB;
constexpr size_t WS_RSTDX = 1 * MiB;
constexpr size_t WS_RSTDM = WS_RSTDX + (size_t)T * 4;
constexpr size_t WS_DT = 2 * MiB;
constexpr size_t WS_SSQ1 = 4 * MiB;
constexpr size_t WS_SSQ2 = 5 * MiB;
constexpr size_t WS_ROUTE = 6 * MiB;
constexpr size_t WS_WIN = 8 * MiB;
constexpr size_t WS_WOUT = 14 * MiB;
constexpr size_t WS_WQP = 16 * MiB;
constexpr size_t WS_WKV = 18 * MiB;
constexpr size_t WS_WO = 22 * MiB;
constexpr size_t WS_WGU = 24 * MiB;
constexpr size_t WS_WD = 88 * MiB;
constexpr size_t WS_KV = 120 * MiB;
constexpr size_t WS_MT = 128 * MiB;
constexpr size_t WS_NT = 144 * MiB;
constexpr size_t WS_MEMB = 160 * MiB;
constexpr size_t WS_LSRC = 164 * MiB;
constexpr size_t WS_TSLOT = 172 * MiB;
constexpr size_t WS_LRS = 180 * MiB;
constexpr size_t WS_A = 192 * MiB;
constexpr size_t WS_H1 = 320 * MiB;
constexpr size_t WS_HBUF = 192 * MiB;
constexpr size_t WS_H2F8 = 720 * MiB;
constexpr size_t WS_PROJ = 448 * MiB;
constexpr size_t WS_Y = 448 * MiB;
constexpr size_t WS_SCORE = 448 * MiB;
constexpr size_t WS_H2 = 800 * MiB;
constexpr size_t WS_XC = 800 * MiB;
constexpr size_t WS_YRAW = 320 * MiB;
constexpr size_t WS_STATES = 800 * MiB;
constexpr size_t WS_PREV = 864 * MiB;
constexpr size_t WS_CDEC = 1 * MiB + 512 * 1024;
constexpr size_t WS_WR = 7 * MiB;
constexpr size_t WS_YCAT = 896 * MiB;
constexpr size_t WS_END = 1024 * MiB;
constexpr int CW_CNT = 64;
constexpr int CW_TCNT = 32768;

typedef __bf16 bf16v2 __attribute__((ext_vector_type(2)));
__device__ __forceinline__ unsigned pk2(float lo, float hi) { bf16v2 v; v[0] = (__bf16)lo; v[1] = (__bf16)hi; return __builtin_bit_cast(unsigned, v); }
__device__ __forceinline__ unsigned f2bf(float f) { return pk2(f, 0.f) & 0xffffu; }
__device__ __forceinline__ unsigned pk_fp8x4(float a, float b, float c, float d) { int w = 0; w = __builtin_amdgcn_cvt_pk_fp8_f32(a, b, w, false); w = __builtin_amdgcn_cvt_pk_fp8_f32(c, d, w, true); return (unsigned)w; }
__device__ __forceinline__ float bf2f(unsigned short b) { return __builtin_bit_cast(float, ((unsigned)b) << 16); }
__device__ __forceinline__ float bflo(unsigned w) { return __builtin_bit_cast(float, w << 16); }
__device__ __forceinline__ float bfhi(unsigned w) { return __builtin_bit_cast(float, w & 0xffff0000u); }
__device__ __forceinline__ float siluf(float v) { return v * __builtin_amdgcn_rcpf(1.f + __builtin_amdgcn_exp2f(v * -LOG2E)); }
#define DPP_ADD(v, ctrl, rmask) v += __builtin_bit_cast(float, __builtin_amdgcn_update_dpp(0, __builtin_bit_cast(int, v), (ctrl), (rmask), 0xF, true))
__device__ __forceinline__ float row16_sum(float v) { DPP_ADD(v, 0xB1, 0xF); DPP_ADD(v, 0x4E, 0xF); DPP_ADD(v, 0x141, 0xF); DPP_ADD(v, 0x140, 0xF); return v; }
__device__ __forceinline__ float wave_sum(float v) {
    v = row16_sum(v); DPP_ADD(v, 0x142, 0xA); DPP_ADD(v, 0x143, 0xC);
    return __builtin_bit_cast(float, __builtin_amdgcn_readlane(__builtin_bit_cast(int, v), 63));
}

__device__ __forceinline__ int tid_from(int wv) { int l; asm volatile("v_mbcnt_lo_u32_b32 %0, -1, 0\n\tv_mbcnt_hi_u32_b32 %0, -1, %0" : "=v"(l)); return (wv << 6) + l; }

namespace pg8 {
constexpr int BM = 256, BK = 64, HALF = 128, HTB = HALF * BK * 2, STAGE_BYTES = 8 * HTB, NXCD = 8, WGM = 8;
__host__ __device__ __forceinline__ int lds_byte(int r, int c) { const int st = (r >> 4) * 2 + (c >> 5), rr = r & 15, cc = c & 31, ob = rr * 64 + cc * 2; return st * 1024 + (ob ^ (((ob >> 9) & 1) << 5)); }
__host__ __device__ __forceinline__ void stage_rc(int b, int& R, int& C) { const int st = b / 1024, sb = b % 1024, swz = sb ^ (((sb >> 9) & 1) << 5); R = (st >> 1) * 16 + swz / 64; C = (st & 1) * 32 + (swz % 64) / 2; }
__host__ __device__ __forceinline__ int lds_byte8(int r, int fq) { return ((r >> 4) * 2 + (fq >> 1)) * 1024 + (r & 15) * 64 + 32 * ((fq & 1) ^ ((r >> 3) & 1)); }
__host__ __device__ __forceinline__ int perm32(int rho) { const int n = rho >> 4, i = rho & 15; return 8 * (i >> 2) + 4 * n + (i & 3); }

struct Unit { int pm, pn; const char* A; const char* B; char* C; int row0; int aux; };

__device__ __forceinline__ unsigned cvt_pk_bf16(float lo, float hi) { bf16v2 v; v[0] = (__bf16)lo; v[1] = (__bf16)hi; return __builtin_bit_cast(unsigned, v); }

__device__ __forceinline__ bool static_map(int i, int G, int c, int nM, int nN, int& pm, int& pn) {
    const int nwg = nM * nN; const long L = (long)i * G + c; if (L >= nwg) return false;
    int wgid = (int)L; { const int q = nwg / NXCD, r = nwg % NXCD, xcd = wgid % NXCD, off = wgid / NXCD; wgid = (xcd < r ? xcd * (q + 1) : r * (q + 1) + (xcd - r) * q) + off; }
    const int nig = WGM * nN, gid = wgid / nig, fm = gid * WGM, gsz = (nM - fm) < WGM ? (nM - fm) : WGM;
    pm = fm + ((wgid % nig) % gsz); pn = (wgid % nig) / gsz; return true;
}

template <class T, class = void> struct has_pref { static constexpr bool value = false; };
template <class T> struct has_pref<T, decltype((void)&T::pref)> { static constexpr bool value = true; };
template <class Epi, class Sched>
__device__ __forceinline__ void gemm_phase(LAS unsigned char* lds, const int K, const Sched& S, const Epi& E, const int wv) {
    int tid_ = tid_from(wv); asm volatile("" : "+v"(tid_));
    const int tid = tid_, wid = __builtin_amdgcn_readfirstlane(tid >> 6), lane = tid & 63, wr = wid >> 2, wc = wid & 3, fr = lane & 15, fq = lane >> 4;
    constexpr bool F8 = Sched::FP8;
    constexpr int ESZ = F8 ? 1 : 2;
    const int nt = K / (F8 ? 128 : BK);
    const int ldb = S.ldb;
    int Rr[2], Cc[2]; unsigned voffB[2], voffA0[2];
#pragma unroll
    for (int i = 0; i < 2; ++i) { int R, C; stage_rc(tid * 16 + i * 8192, R, C); Rr[i] = R; Cc[i] = C; const int Rb = Epi::PERM ? ((R & ~31) + perm32(R & 31)) : R; voffB[i] = (unsigned)(Rb * ldb * ESZ + C * 2);
        voffA0[i] = Sched::GATHER ? 0u : (unsigned)(R * S.lda_() * ESZ + C * 2); }
    const size_t kstep = (size_t)(BK * 2);
    const size_t hstepB = (size_t)HALF * ldb * ESZ;
    const size_t hstepA = Sched::GATHER ? 0 : (size_t)HALF * S.lda_() * ESZ;
    const unsigned ldsw = (unsigned)wid * 1024u;
    const int aoff = lds_byte(wr * 64 + fr, fq * 8), boff = lds_byte(wc * 32 + fr, fq * 8);
#define PG8_SA(b, h) (((b) * 2 + (h)) * HTB)
#define PG8_SB(b, h) ((4 + (b) * 2 + (h)) * HTB)
#define PG8_STAGE_B(bufoff, gbase) do { _Pragma("unroll") for (int _i = 0; _i < 2; ++_i) \
        __builtin_amdgcn_global_load_lds((const unsigned*)((const char*)(gbase) + voffB[_i]), (LAS unsigned*)(lds + (bufoff) + ldsw + _i * 8192), 16, 0, 0); } while (0)
#define PG8_STAGE_A(bufoff, gbase, VA, h) do { _Pragma("unroll") for (int _i = 0; _i < 2; ++_i) \
        __builtin_amdgcn_global_load_lds((const unsigned*)((const char*)(gbase) + (Sched::GATHER ? (size_t)(VA)[h][_i] : (size_t)(h) * hstepA + voffA0[_i])), (LAS unsigned*)(lds + (bufoff) + ldsw + _i * 8192), 16, 0, 0); } while (0)
struct Frag8 { bf16x8 lo, hi; };
#define PG8_RD8(base) ({ Frag8 _f; _f.lo = *(const LAS bf16x8*)(base); _f.hi = *(const LAS bf16x8*)((base) + 1024); __builtin_bit_cast(v8i, _f); })
#define PG8_LDA(dst, b, h) do { if constexpr (F8) { _Pragma("unroll") for (int m = 0; m < 4; ++m) dst##8[m] = PG8_RD8(lds + PG8_SA(b, h) + aoff + m * 2048); } \
        else { _Pragma("unroll") for (int m = 0; m < 4; ++m) _Pragma("unroll") for (int k = 0; k < 2; ++k) dst[m][k] = *(const LAS bf16x8*)(lds + PG8_SA(b, h) + aoff + m * 2048 + k * 1024); } } while (0)
#define PG8_LDB(dst, b, h) do { if constexpr (F8) { _Pragma("unroll") for (int n = 0; n < 2; ++n) dst##8[n] = PG8_RD8(lds + PG8_SB(b, h) + boff + n * 2048); } \
        else { _Pragma("unroll") for (int n = 0; n < 2; ++n) _Pragma("unroll") for (int k = 0; k < 2; ++k) dst[n][k] = *(const LAS bf16x8*)(lds + PG8_SB(b, h) + boff + n * 2048 + k * 1024); } } while (0)
#define PG8_MMA(ai, bj, At, Bt) do { __builtin_amdgcn_s_setprio(1); if constexpr (F8) { _Pragma("unroll") for (int m = 0; m < 4; ++m) _Pragma("unroll") for (int n = 0; n < 2; ++n) \
            asm volatile("v_mfma_scale_f32_16x16x128_f8f6f4 %0, %1, %2, %0, %3, %4 op_sel_hi:[0,0,0]" : "+v"(acc[ai][bj][m][n]) : "v"(Bt##8[n]), "v"(At##8[m]), "v"(scl_b), "v"(scl_a)); } \
        else { _Pragma("unroll") for (int m = 0; m < 4; ++m) _Pragma("unroll") for (int n = 0; n < 2; ++n) _Pragma("unroll") for (int k = 0; k < 2; ++k) \
            acc[ai][bj][m][n] = __builtin_amdgcn_mfma_f32_16x16x32_bf16(Bt[n][k], At[m][k], acc[ai][bj][m][n], 0, 0, 0); } __builtin_amdgcn_s_setprio(0); } while (0)
#define PG8_WAIT_V(n) asm volatile("s_waitcnt vmcnt(" #n ")" ::: "memory")
#define PG8_WAIT_L(n) asm volatile("s_waitcnt lgkmcnt(" #n ")" ::: "memory")
#define PG8_BAR __builtin_amdgcn_s_barrier()
#define PG8_SCHED __builtin_amdgcn_sched_barrier(0)
    Unit cur, nxt; int ui = 0;
    if (!S.next(0, cur)) return;
    f32x4 acc[2][2][4][2];
#pragma unroll
    for (int a = 0; a < 2; ++a)
#pragma unroll
        for (int b = 0; b < 2; ++b)
#pragma unroll
            for (int m = 0; m < 4; ++m)
#pragma unroll
                for (int n = 0; n < 2; ++n) acc[a][b][m][n] = (f32x4){0.f, 0.f, 0.f, 0.f};
    bf16x8 At[4][2], B0[2][2], B1[2][2]; v8i At8[4], B08[2], B18[2];
    int scl_a = Sched::SCALE_A, scl_b = Sched::SCALE_B; if constexpr (F8) asm volatile("" : "+v"(scl_a), "+v"(scl_b));
    unsigned vAc[2][2], vAn[2][2];
    if constexpr (Sched::GATHER) S.rows(cur, Rr, Cc, vAc);
    const char* cA = cur.A; const char* cB = cur.B;
    PG8_STAGE_B(PG8_SB(0, 0), cB); PG8_STAGE_B(PG8_SB(0, 1), cB + hstepB); PG8_STAGE_A(PG8_SA(0, 0), cA, vAc, 0); PG8_STAGE_A(PG8_SA(0, 1), cA, vAc, 1);
    if (wr == 1) PG8_BAR;
    PG8_WAIT_V(2); PG8_BAR;
    PG8_STAGE_B(PG8_SB(1, 0), cB + kstep); PG8_STAGE_A(PG8_SA(1, 0), cA + kstep, vAc, 0); PG8_STAGE_B(PG8_SB(1, 1), cB + hstepB + kstep);
    PG8_WAIT_V(6); PG8_BAR;
    for (;;) {
        const bool has_next = S.next(ui + 1, nxt);
        if constexpr (Sched::GATHER) { if (has_next) S.rows(nxt, Rr, Cc, vAn); else {
#pragma unroll
            for (int h = 0; h < 2; ++h)
#pragma unroll
                for (int i = 0; i < 2; ++i) vAn[h][i] = vAc[h][i]; } }
        const char* nA = has_next ? nxt.A : cA; const char* nB = has_next ? nxt.B : cB;
        const int kreps = S.kdup_();
#pragma unroll 1
        for (int krep = 0; krep < kreps; ++krep)
#pragma unroll 1
        for (int t = 0; t < nt; t += 2) {
            const bool last = (t == nt - 2) && (krep == kreps - 1);
            if constexpr (has_pref<Epi>::value) { if (t == nt - 4 && krep == kreps - 1) E.pref(cur, wv, lds); }
            const char* a1 = cA + (size_t)(t + 1) * kstep;
            const char* a2 = last ? nA : ((t == nt - 2) ? cA : cA + (size_t)(t + 2) * kstep); const char* b2 = last ? nB : ((t == nt - 2) ? cB : cB + (size_t)(t + 2) * kstep);
            const char* a3 = a2 + kstep; const char* b3 = b2 + kstep;
            unsigned v2[2][2];
            if constexpr (Sched::GATHER) {
#pragma unroll
            for (int h = 0; h < 2; ++h)
#pragma unroll
                for (int i = 0; i < 2; ++i) v2[h][i] = last ? vAn[h][i] : vAc[h][i]; }
            PG8_LDB(B0, 0, 0); PG8_LDB(B1, 0, 1); PG8_SCHED; PG8_LDA(At, 0, 0); PG8_STAGE_A(PG8_SA(1, 1), a1, vAc, 1);
            PG8_WAIT_V(8); PG8_WAIT_L(0); PG8_BAR; PG8_MMA(0, 0, At, B0); PG8_MMA(0, 1, At, B1); PG8_BAR; PG8_SCHED;
            PG8_LDA(At, 0, 1); PG8_STAGE_B(PG8_SB(0, 0), b2); PG8_STAGE_B(PG8_SB(0, 1), b2 + hstepB); PG8_STAGE_A(PG8_SA(0, 0), a2, v2, 0);
            PG8_WAIT_V(8); PG8_WAIT_L(0); PG8_BAR; PG8_MMA(1, 0, At, B0); PG8_MMA(1, 1, At, B1); PG8_BAR; PG8_SCHED;
            PG8_LDB(B0, 1, 0); PG8_LDB(B1, 1, 1); PG8_SCHED; PG8_LDA(At, 1, 0); PG8_STAGE_A(PG8_SA(0, 1), a2, v2, 1);
            PG8_WAIT_V(8); PG8_WAIT_L(0); PG8_BAR; PG8_MMA(0, 0, At, B0); PG8_MMA(0, 1, At, B1); PG8_BAR; PG8_SCHED;
            PG8_LDA(At, 1, 1); PG8_STAGE_B(PG8_SB(1, 0), b3); PG8_STAGE_B(PG8_SB(1, 1), b3 + hstepB); PG8_STAGE_A(PG8_SA(1, 0), a3, v2, 0);
            PG8_WAIT_V(8); PG8_WAIT_L(0); PG8_BAR; PG8_MMA(1, 0, At, B0); PG8_MMA(1, 1, At, B1); PG8_BAR; PG8_SCHED;
        }
        if (wr == 0) PG8_BAR;
        if constexpr (F8) asm volatile("s_nop 15\n\ts_nop 7" : "+v"(acc[1][1][0][0]), "+v"(acc[1][1][0][1]), "+v"(acc[1][1][1][0]), "+v"(acc[1][1][1][1]), "+v"(acc[1][1][2][0]), "+v"(acc[1][1][2][1]), "+v"(acc[1][1][3][0]), "+v"(acc[1][1][3][1]) :: "memory");
        E(acc, cur, wr, wc, fr, fq, lds);
        if (S.edup_()) E(acc, cur, wr, wc, fr, fq, lds);
        if (!has_next) break;
#pragma unroll
        for (int a = 0; a < 2; ++a)
#pragma unroll
            for (int b = 0; b < 2; ++b)
#pragma unroll
                for (int m = 0; m < 4; ++m)
#pragma unroll
                    for (int n = 0; n < 2; ++n) acc[a][b][m][n] = (f32x4){0.f, 0.f, 0.f, 0.f};
        cur = nxt; cA = nA; cB = nB; ++ui;
        if constexpr (Sched::GATHER) {
#pragma unroll
        for (int h = 0; h < 2; ++h)
#pragma unroll
            for (int i = 0; i < 2; ++i) vAc[h][i] = vAn[h][i]; }
        if (wr == 1) PG8_BAR;
    }
    PG8_WAIT_V(0);
    PG8_BAR;
#undef PG8_SA
#undef PG8_SB
#undef PG8_STAGE_A
#undef PG8_STAGE_B
#undef PG8_LDA
#undef PG8_RD8
#undef PG8_LDB
#undef PG8_MMA
#undef PG8_WAIT_V
#undef PG8_WAIT_L
#undef PG8_SCHED
}

struct DenseRows {
    static constexpr bool GATHER = false, FP8 = false; static constexpr int SCALE_A = 0x7f7f7f7f, SCALE_B = 0x7f7f7f7f;
    int lda; int kdup = 1; int edup = 0;
    __device__ __forceinline__ int lda_() const { return lda; }
    __device__ __forceinline__ int kdup_() const { return kdup; }
    __device__ __forceinline__ int edup_() const { return edup; }
    __device__ __forceinline__ void rows(const Unit&, const int (&)[2], const int (&)[2], unsigned (&)[2][2]) const {}
};
struct PlainSched : DenseRows {
    const char* A; const char* B; char* C; int ldb, ldc, esz, nM, nN, G, c, bper; size_t bstride;
    __device__ __forceinline__ bool next(int i, Unit& u) const {
        int pm, pn; if (!static_map(i, G, c, nM, nN, pm, pn)) return false;
        u.pm = pm; u.pn = pn; u.A = A + (size_t)pm * BM * lda * 2; u.B = B + (size_t)pn * BM * ldb * 2 + (bper ? (size_t)(pm / bper) * bstride : 0);
        u.C = C + ((size_t)pm * BM * ldc + (size_t)pn * BM) * esz; u.row0 = pm * BM; u.aux = 0; return true;
    }
};
template <int WS, int AS> struct PlainSched8 : PlainSched {
    static constexpr bool FP8 = true; static constexpr int SCALE_A = AS * 0x01010101, SCALE_B = WS * 0x01010101;
    __device__ __forceinline__ bool next(int i, Unit& u) const {
        int pm, pn; if (!static_map(i, G, c, nM, nN, pm, pn)) return false;
        u.pm = pm; u.pn = pn; u.A = A + (size_t)pm * BM * lda; u.B = B + (size_t)pn * BM * ldb + (bper ? (size_t)(pm / bper) * bstride : 0);
        u.C = C + ((size_t)pm * BM * ldc + (size_t)pn * BM) * esz; u.row0 = pm * BM; u.aux = 0; return true;
    }
};
}
using pg8::Unit; using pg8::cvt_pk_bf16;

struct EpiRowScale {
    static constexpr bool PERM = true;
    const float* scale; int ldc; float mul = 1.f; bool f8out = false;
    __device__ __forceinline__ void operator()(f32x4 (&acc)[2][2][4][2], const Unit& u, int wr, int wc, int fr, int fq, LAS unsigned char*) const {
        asm volatile("" : "+v"(fr), "+v"(fq));
        const int r0 = wr * 64 + fr, c0 = wc * 32 + 8 * fq;
#pragma unroll
        for (int ai = 0; ai < 2; ++ai)
#pragma unroll
            for (int m = 0; m < 4; ++m) { const int r = r0 + ai * 128 + m * 16; const float s = (scale ? scale[u.row0 + r] : 1.f) * mul;
                bf16_t* rowp = (bf16_t*)u.C + (size_t)r * ldc + c0; unsigned char* rowp8 = (unsigned char*)u.C + (size_t)r * ldc + c0;
#pragma unroll
                for (int bj = 0; bj < 2; ++bj) { const f32x4 v0 = acc[ai][bj][m][0] * s, v1 = acc[ai][bj][m][1] * s;
                    if (f8out) { u32x2 w8; w8.x = pk_fp8x4(v0[0], v0[1], v0[2], v0[3]); w8.y = pk_fp8x4(v1[0], v1[1], v1[2], v1[3]); *(u32x2*)(rowp8 + bj * 128) = w8; }
                    else { u32x4 w; w.x = cvt_pk_bf16(v0[0], v0[1]); w.y = cvt_pk_bf16(v0[2], v0[3]); w.z = cvt_pk_bf16(v1[0], v1[1]); w.w = cvt_pk_bf16(v1[2], v1[3]);
                        *(u32x4*)(rowp + bj * 128) = w; } } }
    }
};
struct EpiResid {
    static constexpr bool PERM = true;
    const bf16_t* res; float* ssq; unsigned char* h8 = nullptr;
    __device__ __forceinline__ void pref(const Unit& u, const int wv, LAS unsigned char* lds) const {
        int tid = tid_from(wv); asm volatile("" : "+v"(tid));
        const char* p = (const char*)(res + (size_t)(u.row0 + (tid >> 1)) * 1024 + u.pn * 256) + (tid & 1) * 256;
        LAS unsigned* dump = (LAS unsigned*)(lds + pg8::STAGE_BYTES + 12288 + wv * 256);
        __builtin_amdgcn_global_load_lds((const unsigned*)p, dump, 4, 0, 0);
        __builtin_amdgcn_global_load_lds((const unsigned*)(p + 128), dump, 4, 0, 0);
    }
    __device__ __forceinline__ void operator()(f32x4 (&acc)[2][2][4][2], const Unit& u, int wr, int wc, int fr, int fq, LAS unsigned char* lds) const {
        asm volatile("" : "+v"(fr), "+v"(fq));
        const int r0 = wr * 64 + fr, c0 = wc * 32 + 8 * fq;
        LAS float* tab = (LAS float*)(lds + pg8::STAGE_BYTES);
        u32x4 rv[2][4][2];
#pragma unroll
        for (int ai = 0; ai < 2; ++ai)
#pragma unroll
            for (int m = 0; m < 4; ++m)
#pragma unroll
                for (int bj = 0; bj < 2; ++bj) rv[ai][m][bj] = *(const u32x4*)(res + (size_t)(u.row0 + r0 + ai * 128 + m * 16) * 1024 + u.pn * 256 + c0 + bj * 128);
#pragma unroll
        for (int ai = 0; ai < 2; ++ai)
#pragma unroll
            for (int m = 0; m < 4; ++m) { const int r = r0 + ai * 128 + m * 16; float q = 0.f;
                bf16_t* rowp = (bf16_t*)u.C + (size_t)r * 1024 + c0;
#pragma unroll
                for (int bj = 0; bj < 2; ++bj) { f32x4 v0 = acc[ai][bj][m][0], v1 = acc[ai][bj][m][1]; const u32x4 a = rv[ai][m][bj];
                    v0 += (f32x4){bflo(a.x), bfhi(a.x), bflo(a.y), bfhi(a.y)}; v1 += (f32x4){bflo(a.z), bfhi(a.z), bflo(a.w), bfhi(a.w)};
                    q += (v0[0] * v0[0] + v0[1] * v0[1]) + (v0[2] * v0[2] + v0[3] * v0[3]) + (v1[0] * v1[0] + v1[1] * v1[1]) + (v1[2] * v1[2] + v1[3] * v1[3]);
                    u32x4 w; w.x = cvt_pk_bf16(v0[0], v0[1]); w.y = cvt_pk_bf16(v0[2], v0[3]); w.z = cvt_pk_bf16(v1[0], v1[1]); w.w = cvt_pk_bf16(v1[2], v1[3]);
                    *(u32x4*)(rowp + bj * 128) = w;
                    if (h8) { u32x2 w8; w8.x = pk_fp8x4(v0[0], v0[1], v0[2], v0[3]); w8.y = pk_fp8x4(v1[0], v1[1], v1[2], v1[3]); *(u32x2*)(h8 + (size_t)(u.row0 + r) * 1024 + u.pn * 256 + c0 + bj * 128) = w8; } }
                q += __shfl_xor(q, 16); q += __shfl_xor(q, 32);
                if (fq == 0) tab[r * 4 + wc] = q; }
        asm volatile("s_waitcnt lgkmcnt(0)" ::: "memory"); __builtin_amdgcn_s_barrier(); asm volatile("" ::: "memory");
        { const int trow = (wr * 4 + wc) * 64 + fq * 16 + fr; if (trow < 256) { const f32x4 p = *(const LAS f32x4*)(tab + trow * 4); ssq[(size_t)(u.row0 + trow) * 4 + u.pn] = (p[0] + p[1]) + (p[2] + p[3]); } }
        asm volatile("s_waitcnt lgkmcnt(0)" ::: "memory"); __builtin_amdgcn_s_barrier(); asm volatile("" ::: "memory");
    }
};
struct EpiScoreF32 {
    static constexpr bool PERM = false;
    const float* ssq;
    __device__ __forceinline__ void operator()(f32x4 (&acc)[2][2][4][2], const Unit& u, int wr, int wc, int fr, int fq, LAS unsigned char*) const {
        asm volatile("" : "+v"(fr), "+v"(fq));
        const int r0 = wr * 64 + fr, c0 = wc * 32 + 4 * fq;
#pragma unroll
        for (int ai = 0; ai < 2; ++ai)
#pragma unroll
            for (int m = 0; m < 4; ++m) { const int r = r0 + ai * 128 + m * 16; const f32x4 p = *(const f32x4*)(ssq + (size_t)(u.row0 + r) * 4);
                const float s = rsqrtf(((p[0] + p[1]) + (p[2] + p[3])) * (1.f / 1024.f) + EPS);
                float* rowp = (float*)u.C + (size_t)r * 1024 + c0;
#pragma unroll
                for (int bj = 0; bj < 2; ++bj)
#pragma unroll
                    for (int n = 0; n < 2; ++n) *(f32x4*)(rowp + bj * 128 + n * 16) = acc[ai][bj][m][n] * s; }
    }
};
struct EpiSoftmax {
    static constexpr bool PERM = true;
    const float* ssq;
    __device__ __forceinline__ void operator()(f32x4 (&acc)[2][2][4][2], const Unit& u, int wr, int wc, int fr, int fq, LAS unsigned char* lds) const {
        LAS float* tabM = (LAS float*)(lds + pg8::STAGE_BYTES); LAS float* tabS = tabM + 1024;
        asm volatile("" : "+v"(fr), "+v"(fq));
        const int r0 = wr * 64 + fr, c0 = wc * 32 + 8 * fq;
        f32x4 pq[2][4];
#pragma unroll
        for (int ai = 0; ai < 2; ++ai)
#pragma unroll
            for (int m = 0; m < 4; ++m) pq[ai][m] = *(const f32x4*)(ssq + (size_t)(u.row0 + r0 + ai * 128 + m * 16) * 4);
#pragma unroll
        for (int ai = 0; ai < 2; ++ai)
#pragma unroll
            for (int m = 0; m < 4; ++m) { const int r = r0 + ai * 128 + m * 16; const f32x4 p = pq[ai][m];
                const float s = rsqrtf(((p[0] + p[1]) + (p[2] + p[3])) * (1.f / 1024.f) + EPS); float mx = -3.0e38f;
#pragma unroll
                for (int bj = 0; bj < 2; ++bj)
#pragma unroll
                    for (int n = 0; n < 2; ++n) { f32x4 v = acc[ai][bj][m][n] * s; acc[ai][bj][m][n] = v; mx = fmaxf(mx, fmaxf(fmaxf(v[0], v[1]), fmaxf(v[2], v[3]))); }
                mx = fmaxf(mx, __shfl_xor(mx, 16)); mx = fmaxf(mx, __shfl_xor(mx, 32));
                if (fq == 0) tabM[r * 4 + wc] = mx; }
        asm volatile("s_waitcnt lgkmcnt(0)" ::: "memory"); __builtin_amdgcn_s_barrier(); asm volatile("" ::: "memory");
#pragma unroll
        for (int ai = 0; ai < 2; ++ai)
#pragma unroll
            for (int m = 0; m < 4; ++m) { const int r = r0 + ai * 128 + m * 16; const f32x4 m4 = *(const LAS f32x4*)(tabM + r * 4);
                const float mx = fmaxf(fmaxf(m4[0], m4[1]), fmaxf(m4[2], m4[3])); float sum = 0.f;
#pragma unroll
                for (int bj = 0; bj < 2; ++bj)
#pragma unroll
                    for (int n = 0; n < 2; ++n) { f32x4 v = acc[ai][bj][m][n];
#pragma unroll
                        for (int j = 0; j < 4; ++j) { v[j] = __builtin_amdgcn_exp2f(v[j] - mx); sum += v[j]; }
                        acc[ai][bj][m][n] = v; }
                sum += __shfl_xor(sum, 16); sum += __shfl_xor(sum, 32);
                if (fq == 0) tabS[r * 4 + wc] = sum; }
        asm volatile("s_waitcnt lgkmcnt(0)" ::: "memory"); __builtin_amdgcn_s_barrier(); asm volatile("" ::: "memory");
#pragma unroll
        for (int ai = 0; ai < 2; ++ai)
#pragma unroll
            for (int m = 0; m < 4; ++m) { const int r = r0 + ai * 128 + m * 16; const f32x4 s4 = *(const LAS f32x4*)(tabS + r * 4);
                const float inv = (ATT_O_F8 ? 256.f : 1.f) / ((s4[0] + s4[1]) + (s4[2] + s4[3])); bf16_t* rowp = (bf16_t*)u.C + (size_t)r * 1024 + c0; unsigned char* rowp8 = (unsigned char*)u.C + (size_t)r * 1024 + c0;
#pragma unroll
                for (int bj = 0; bj < 2; ++bj) { const f32x4 v0 = acc[ai][bj][m][0] * inv, v1 = acc[ai][bj][m][1] * inv;
                    if (ATT_O_F8) { u32x2 w8; w8.x = pk_fp8x4(v0[0], v0[1], v0[2], v0[3]); w8.y = pk_fp8x4(v1[0], v1[1], v1[2], v1[3]); *(u32x2*)(rowp8 + bj * 128) = w8; }
                    else { u32x4 w; w.x = cvt_pk_bf16(v0[0], v0[1]); w.y = cvt_pk_bf16(v0[2], v0[3]); w.z = cvt_pk_bf16(v1[0], v1[1]); w.w = cvt_pk_bf16(v1[2], v1[3]);
                        *(u32x4*)(rowp + bj * 128) = w; } } }
    }
};
struct EpiSwiGLU {
    static constexpr bool PERM = true;
    const float* lrs;
    __device__ __forceinline__ void operator()(f32x4 (&acc)[2][2][4][2], const Unit& u, int wr, int wc, int fr, int fq, LAS unsigned char*) const {
        asm volatile("" : "+v"(fr), "+v"(fq));
        const int r0 = wr * 64 + fr, c0 = wc * 32 + 8 * fq;
        float rsv[2][4];
#pragma unroll
        for (int ai = 0; ai < 2; ++ai)
#pragma unroll
            for (int m = 0; m < 4; ++m) { const int r = r0 + ai * 128 + m * 16; rsv[ai][m] = r < u.row0 ? lrs[u.aux + r] : 0.f; }
#pragma unroll
        for (int ai = 0; ai < 2; ++ai)
#pragma unroll
            for (int m = 0; m < 4; ++m) { const int r = r0 + ai * 128 + m * 16; unsigned char* rowp = (unsigned char*)u.C + ((size_t)r * DEXP + c0) * (MOE_DN_F8 ? 1 : 2);
                const float rs = rsv[ai][m];
                const f32x4 g0 = acc[ai][0][m][0] * rs, g1 = acc[ai][0][m][1] * rs, u0 = acc[ai][1][m][0] * rs, u1 = acc[ai][1][m][1] * rs;
                f32x4 h0, h1;
#pragma unroll
                for (int j = 0; j < 4; ++j) { h0[j] = siluf(g0[j]) * u0[j]; h1[j] = siluf(g1[j]) * u1[j]; }
                if (MOE_DN_F8) { u32x2 w; w.x = pk_fp8x4(h0[0], h0[1], h0[2], h0[3]); w.y = pk_fp8x4(h1[0], h1[1], h1[2], h1[3]); *(u32x2*)rowp = w; }
                else { u32x4 w; w.x = cvt_pk_bf16(h0[0], h0[1]); w.y = cvt_pk_bf16(h0[2], h0[3]); w.z = cvt_pk_bf16(h1[0], h1[1]); w.w = cvt_pk_bf16(h1[2], h1[3]); *(u32x4*)rowp = w; } }
    }
};
struct MoeTab { const LAS int* t; __device__ __forceinline__ int ts(int e) const { return __builtin_amdgcn_readfirstlane(t[e]); } __device__ __forceinline__ int cnt(int e) const { return __builtin_amdgcn_readfirstlane(t[64 + e]); } };
__device__ __forceinline__ void moe_build_table(LAS unsigned char* lds, const unsigned* ctl, const int wv) {
    LAS int* t = (LAS int*)(lds + pg8::STAGE_BYTES + 4096);
    int tid_ = tid_from(wv); asm volatile("" : "+v"(tid_));
    if (tid_ == 0) { int acc = 0; for (int e = 0; e < NEXP; ++e) { const int c = (int)__hip_atomic_load(ctl + CW_CNT + e, __ATOMIC_RELAXED, __HIP_MEMORY_SCOPE_AGENT)  ; t[e] = acc; t[64 + e] = c; acc += (c + 255) >> 8; } t[NEXP] = acc; }
    __syncthreads();
}
__device__ __forceinline__ bool moe_map(const MoeTab& tb, int i, int G, int c, int& e, int& rt, int& pn, int& pmg) {
    const int nM = tb.ts(NEXP); int pm; if (!pg8::static_map(i, G, c, nM, 4, pm, pn)) return false;
    e = 0; for (int k = 1; k < NEXP; ++k) if (tb.ts(k) <= pm) e = k;
    rt = pm - tb.ts(e); pmg = pm; return true;
}
struct GateUpSched {
    static constexpr bool GATHER = true, FP8 = (MOE_GU_F8 != 0); static constexpr int SCALE_A = 0x7f7f7f7f, SCALE_B = 0x7a7a7a7a;
    static constexpr int ES = FP8 ? 1 : 2, HES = (MOE_DN_F8 != 0) ? 1 : 2;
    __device__ __forceinline__ int lda_() const { return 0; }
    __device__ __forceinline__ int kdup_() const { return 1; }
    __device__ __forceinline__ int edup_() const { return 0; }
    const char* hb; const char* wgu; char* hbuf; const int* lsrc; MoeTab tb; int ldb, G, c;
    __device__ __forceinline__ bool next(int i, Unit& u) const {
        int e, rt, pn, pmg; if (!moe_map(tb, i, G, c, e, rt, pn, pmg)) return false;
        u.pm = pmg; u.pn = pn; u.A = hb; u.B = wgu + ((size_t)e * 1024 + (size_t)pn * 256) * 1024 * ES; u.C = hbuf + ((size_t)pmg * 256 * DEXP + (size_t)pn * 128) * HES;
        u.aux = e * T + rt * 256; const int left = tb.cnt(e) - rt * 256; u.row0 = left < 256 ? left : 256; return true;
    }
    __device__ __forceinline__ void rows(const Unit& u, const int (&Rr)[2], const int (&Cc)[2], unsigned (&vA)[2][2]) const {
#pragma unroll
        for (int h = 0; h < 2; ++h)
#pragma unroll
            for (int i = 0; i < 2; ++i) { const int r = h * 128 + Rr[i]; const int tok = r < u.row0 ? lsrc[u.aux + r] : 0; vA[h][i] = (unsigned)(tok * 1024 * ES + Cc[i] * 2); }
    }
};
struct DownSched : pg8::DenseRows {
    static constexpr bool FP8 = (MOE_DN_F8 != 0); static constexpr int SCALE_A = 0x7f7f7f7f, SCALE_B = 0x7a7a7a7a; static constexpr int ES = FP8 ? 1 : 2;
    const char* hbuf; const char* wd; char* ysort; MoeTab tb; int ldb, G, c;
    __device__ __forceinline__ bool next(int i, Unit& u) const {
        int e, rt, pn, pmg; if (!moe_map(tb, i, G, c, e, rt, pn, pmg)) return false;
        u.pm = pmg; u.pn = pn; u.A = hbuf + (size_t)pmg * 256 * DEXP * ES; u.B = wd + ((size_t)e * 1024 + (size_t)pn * 256) * DEXP * ES; u.C = ysort + ((size_t)pmg * 256 * 1024 + (size_t)pn * 256);
        u.aux = e * T + rt * 256; const int left = tb.cnt(e) - rt * 256; u.row0 = left < 256 ? left : 256; return true;
    }
};
struct FoldSched : pg8::DenseRows {
    const char* kv; const char* wq; const char* wo; char* mt; char* nt; int ldb, G, c;
    __device__ __forceinline__ bool next(int i, Unit& u) const {
        const int L0 = i * G + c; if (L0 >= 256 || i > 0) return false;
        const int mode = L0 >> 7, L = L0 & 127, b = L >> 4, h = (L >> 2) & 3, q = L & 3;
        if (mode == 0) { u.A = kv + ((size_t)b * 256 * 2048 + h * 256) * 2; u.B = wq + ((size_t)q * 256 * 1024 + h * 256) * 2; u.C = mt + (((size_t)b * 1024 + h * 256) * 1024 + q * 256) * (ATT_S_F8 ? 1 : 2); }
        else { u.A = wo + ((size_t)q * 256 * 1024 + h * 256) * 2; u.B = kv + ((size_t)b * 256 * 2048 + 1024 + h * 256) * 2; u.C = nt + (((size_t)b * 1024 + q * 256) * 1024 + h * 256) * (ATT_O_F8 ? 1 : 2); }
        u.pm = 0; u.pn = 0; u.row0 = 0; u.aux = 0; return true;
    }
};

template <bool F8 = false> __device__ __forceinline__ void p0_tr64(const float* W, int ldw, void* WTv, int ldo, const float* gain, int glim, LAS float* scr, int k0, int lane, float scal = 1.f) {
    bf16_t* WT = (bf16_t*)WTv;
    f32x4 v[16]; const int kq = lane >> 4, n4 = (lane & 15) * 4;
#pragma unroll
    for (int i = 0; i < 16; ++i) v[i] = *(const f32x4*)(W + (size_t)(k0 + 4 * i + kq) * ldw + n4);
#pragma unroll
    for (int i = 0; i < 16; ++i) { const int k = 4 * i + kq; const float g = ((gain && (k0 + k) < glim) ? gain[k0 + k] : 1.f) * scal; LAS float* d = scr + k * 65 + n4;
        d[0] = v[i][0] * g; d[1] = v[i][1] * g; d[2] = v[i][2] * g; d[3] = v[i][3] * g; }
    asm volatile("s_waitcnt lgkmcnt(0)" ::: "memory");
    const int c = lane & 7;
#pragma unroll
    for (int j = 0; j < 8; ++j) { const int n = (lane >> 3) + 8 * j; const LAS float* s = scr + (8 * c) * 65 + n;
        if (F8) { u32x2 o; o.x = pk_fp8x4(s[0 * 65], s[1 * 65], s[2 * 65], s[3 * 65]); o.y = pk_fp8x4(s[4 * 65], s[5 * 65], s[6 * 65], s[7 * 65]); *(u32x2*)((unsigned char*)WTv + (size_t)n * ldo + k0 + 8 * c) = o; }
        else { u32x4 o; o.x = pk2(s[0 * 65], s[1 * 65]); o.y = pk2(s[2 * 65], s[3 * 65]); o.z = pk2(s[4 * 65], s[5 * 65]); o.w = pk2(s[6 * 65], s[7 * 65]);
            *(u32x4*)(WT + (size_t)n * ldo + k0 + 8 * c) = o; } }
    asm volatile("s_waitcnt lgkmcnt(0)" ::: "memory");
}

struct Params {
    const float* in[26]; float* out; unsigned char* ws;
};

__device__ __forceinline__ void p0_prologue(const Params& P, LAS unsigned char* lds, int vcu, int G, const int wv, const int parts = 3) {
    int tid_ = tid_from(wv); asm volatile("" : "+v"(tid_));
    const int tid = tid_, lane = tid & 63, wave = __builtin_amdgcn_readfirstlane(tid >> 6);
    const int gw = vcu * 8 + wave, NGW = G * 8;
    unsigned char* ws = P.ws;
    const float *w_in = P.in[4], *w_out = P.in[12], *w_q = P.in[14], *w_kv = P.in[15], *w_o = P.in[16], *w_gate = P.in[22], *w_up = P.in[23], *w_down = P.in[24];
    const float *norm_mem = P.in[2], *norm_mix = P.in[3], *norm_gate = P.in[10], *norm_xattn = P.in[13], *norm_moe = P.in[17];
    if (parts & 1) {
        LAS bf16_t* wtab = (LAS bf16_t*)lds;
#pragma unroll
        for (int it = 0; it < 32; ++it) { const int idx = tid + 512 * it, n = idx >> 10, k = idx & 1023; float v = 0.f;
            if (n < 8) v = w_in[(size_t)k * INCOLS + 1280 + n] * norm_mix[k];
            const unsigned hi = f2bf(v); const float rem = v - __builtin_bit_cast(float, hi << 16);
            wtab[idx] = (bf16_t)hi; wtab[16384 + idx] = (bf16_t)f2bf(rem); }
        __syncthreads();
        const float* x = P.in[0]; bf16_t* xb = (bf16_t*)(ws + WS_A); float* rstdx = (float*)(ws + WS_RSTDX); float* dtb = (float*)(ws + WS_DT); const float* dt_bias = P.in[7];
        const int fr = lane & 15, fq = lane >> 4;
        const int rpw = T / NGW, mbase = gw * rpw;
#pragma unroll 1
        for (int m0 = mbase; m0 < mbase + rpw; m0 += 16) {
            const float* xrow = x + (size_t)(m0 + fr) * D + 8 * fq; bf16_t* orow = xb + (size_t)(m0 + fr) * D + 8 * fq;
            int woff = fr * 1024 + 8 * fq; asm volatile("" : "+v"(woff));
            const LAS bf16_t* wl = wtab + woff;
            f32x4 acc = (f32x4){0.f, 0.f, 0.f, 0.f}; float ssq = 0.f;
            f32x4 xa[8][2], xbuf[8][2];
#define P0_LD(X, ks0) do { _Pragma("unroll") for (int _q = 0; _q < 8; ++_q) { X[_q][0] = *(const f32x4*)(xrow + 32 * ((ks0) + _q)); X[_q][1] = *(const f32x4*)(xrow + 32 * ((ks0) + _q) + 4); } } while (0)
#define P0_DO(X, ks0) do { _Pragma("unroll") for (int _q = 0; _q < 8; ++_q) { const f32x4 a = X[_q][0], b = X[_q][1]; \
                ssq += (a[0] * a[0] + a[1] * a[1]) + (a[2] * a[2] + a[3] * a[3]) + (b[0] * b[0] + b[1] * b[1]) + (b[2] * b[2] + b[3] * b[3]); \
                u32x4 h; h.x = pk2(a[0], a[1]); h.y = pk2(a[2], a[3]); h.z = pk2(b[0], b[1]); h.w = pk2(b[2], b[3]); \
                u32x4 l; l.x = pk2(a[0] - bflo(h.x), a[1] - bfhi(h.x)); l.y = pk2(a[2] - bflo(h.y), a[3] - bfhi(h.y)); l.z = pk2(b[0] - bflo(h.z), b[1] - bfhi(h.z)); l.w = pk2(b[2] - bflo(h.w), b[3] - bfhi(h.w)); \
                *(u32x4*)(orow + 32 * ((ks0) + _q)) = h; \
                const bf16x8 wh = *(const LAS bf16x8*)(wl + 32 * ((ks0) + _q)), wlo = *(const LAS bf16x8*)(wl + 16384 + 32 * ((ks0) + _q)); \
                const bf16x8 xh = __builtin_bit_cast(bf16x8, h), xl = __builtin_bit_cast(bf16x8, l); \
                acc = __builtin_amdgcn_mfma_f32_16x16x32_bf16(wh, xh, acc, 0, 0, 0); acc = __builtin_amdgcn_mfma_f32_16x16x32_bf16(wh, xl, acc, 0, 0, 0); acc = __builtin_amdgcn_mfma_f32_16x16x32_bf16(wlo, xh, acc, 0, 0, 0); \
                __builtin_amdgcn_sched_barrier(0); asm volatile("s_nop 15\n\ts_nop 15" : "+v"(acc)); __builtin_amdgcn_sched_barrier(0); } } while (0)
            P0_LD(xa, 0);
            P0_LD(xbuf, 8);  P0_DO(xa, 0);
            P0_LD(xa, 16);   P0_DO(xbuf, 8);
            P0_LD(xbuf, 24); P0_DO(xa, 16);
            P0_DO(xbuf, 24);
#undef P0_LD
#undef P0_DO
            ssq += __shfl_xor(ssq, 16); ssq += __shfl_xor(ssq, 32);
            const float rstd = rsqrtf(ssq * (1.f / D) + EPS);
            if (fq == 0) rstdx[m0 + fr] = rstd;
            if (fq < 2) { const f32x4 bb = *(const f32x4*)(dt_bias + 4 * fq); f32x4 o;
#pragma unroll
                for (int e = 0; e < 4; ++e) { const float raw = acc[e] * rstd + bb[e]; o[e] = raw > 20.f ? raw : log1pf(__expf(raw)); }
                *(f32x4*)(dtb + (size_t)(m0 + fr) * 8 + 4 * fq) = o; }
        }
        __syncthreads();
    }
    if (!(parts & 2)) return;
    LAS float* scr = (LAS float*)(lds + wave * 16640);
    constexpr int I_IN = 16 * 44, I_OUT = 16 * 16, I_KV = 16 * 32, I_O = 16 * 16, I_GU = 32 * 2 * 16 * 8, I_DN = 32 * 8 * 16;
    constexpr int NITEMS = I_IN + I_OUT + I_KV + I_O + I_GU + I_DN;
    for (int it = gw; it < NITEMS; it += NGW) {
        int r = it;
        if (r < I_IN) { const int kb = r / 44, nb = r % 44, n0 = nb * 64, sc = n0 < 1280 ? n0 : n0 + 8;
            p0_tr64(w_in + sc, INCOLS, (bf16_t*)(ws + WS_WIN) + (size_t)n0 * 1024, 1024, norm_mix, 1024, scr, kb * 64, lane); continue; } r -= I_IN;
        if (r < I_OUT) { const int kb = r / 16, nb = r % 16;
            p0_tr64(w_out + nb * 64, 1024, (bf16_t*)(ws + WS_WOUT) + (size_t)nb * 64 * 1024, 1024, norm_gate, 512, scr, kb * 64, lane); continue; } r -= I_OUT;
        if (r < I_KV) { const int kb = r / 32, nb = r % 32;
            p0_tr64(w_kv + nb * 64, 2048, (bf16_t*)(ws + WS_WKV) + (size_t)nb * 64 * 1024, 1024, norm_mem, 1024, scr, kb * 64, lane); continue; } r -= I_KV;
        if (r < I_O) { const int kb = r / 16, nb = r % 16;
            p0_tr64(w_o + nb * 64, 1024, (bf16_t*)(ws + WS_WO) + (size_t)nb * 64 * 1024, 1024, nullptr, 0, scr, kb * 64, lane); continue; } r -= I_O;
        if (r < I_GU) { const int e = r / 256, q = r % 256, up = q / 128, q2 = q % 128, kb = q2 / 8, nb = q2 % 8;
            const float* src = (up ? w_up : w_gate) + (size_t)e * 1024 * 512 + nb * 64; const int pn = nb / 2, j0 = (nb % 2) * 64 + up * 128;
            if (MOE_GU_F8) p0_tr64<true>(src, 512, (unsigned char*)(ws + WS_WGU) + ((size_t)e * 1024 + pn * 256 + j0) * 1024, 1024, norm_moe, 1024, scr, kb * 64, lane, 32.f);
            else p0_tr64<false>(src, 512, (bf16_t*)(ws + WS_WGU) + ((size_t)e * 1024 + pn * 256 + j0) * 1024, 1024, norm_moe, 1024, scr, kb * 64, lane); continue; } r -= I_GU;
        { const int e = r / 128, q = r % 128, kb = q / 16, nb = q % 16;
            if (MOE_DN_F8) p0_tr64<true>(w_down + (size_t)e * 512 * 1024 + nb * 64, 1024, (unsigned char*)(ws + WS_WD) + ((size_t)e * 1024 + nb * 64) * 512, 512, nullptr, 0, scr, kb * 64, lane, 32.f);
            else p0_tr64<false>(w_down + (size_t)e * 512 * 1024 + nb * 64, 1024, (bf16_t*)(ws + WS_WD) + ((size_t)e * 1024 + nb * 64) * 512, 512, nullptr, 0, scr, kb * 64, lane); }
    }
    { const int gt = vcu * 512 + tid, NT_ = G * 512; const float sc = LOG2E / 16.f;
        for (int i = gt; i < 1024 * 1024 / 4; i += NT_) { const f32x4 v = ((const f32x4*)w_q)[i]; const float g = norm_xattn[i >> 8] * sc;
            u32x2 o; o.x = pk2(v[0] * g, v[1] * g); o.y = pk2(v[2] * g, v[3] * g); ((u32x2*)(ws + WS_WQP))[i] = o; } }
    { const int gt = vcu * 512 + tid, NT_ = G * 512; const float* w_rg = P.in[18]; const float* w_re = P.in[20]; bf16_t* wr = (bf16_t*)(ws + WS_WR);
        for (int i = gt; i < 96 * 1024; i += NT_) { const int R = i >> 10, k = i & 1023, nt = R >> 4, j = 16 * (nt >> 1) + (R & 15); float v = 0.f;
            if (j < 36) v = (j < 4 ? w_rg[k * 4 + j] : w_re[k * 32 + j - 4]) * norm_moe[k];
            const unsigned hi = f2bf(v); const float rem = v - __builtin_bit_cast(float, hi << 16);
            wr[i] = (bf16_t)((nt & 1) ? f2bf(rem) : hi); } }
    { const float* mem = P.in[1]; bf16_t* mb = (bf16_t*)(ws + WS_MEMB); float* rstdm = (float*)(ws + WS_RSTDM);
        for (int m = gw; m < NMEM; m += NGW) {
            const f32x4* xr = (const f32x4*)(mem + (size_t)m * D) + lane; f32x4 v[4]; float s = 0.f;
#pragma unroll
            for (int j = 0; j < 4; ++j) { v[j] = xr[64 * j]; s += (v[j][0] * v[j][0] + v[j][1] * v[j][1]) + (v[j][2] * v[j][2] + v[j][3] * v[j][3]); }
            s = wave_sum(s);
            u32x2* o8 = (u32x2*)(mb + (size_t)m * D) + lane;
#pragma unroll
            for (int j = 0; j < 4; ++j) { u32x2 o; o.x = pk2(v[j][0], v[j][1]); o.y = pk2(v[j][2], v[j][3]); o8[64 * j] = o; }
            if (lane == 0) rstdm[m] = rsqrtf(s * (1.f / D) + EPS);
        } }
}

__device__ __forceinline__ void lds_barrier() { asm volatile("s_waitcnt lgkmcnt(0)" ::: "memory"); __builtin_amdgcn_s_barrier(); asm volatile("" ::: "memory"); }

typedef float f32x16 __attribute__((ext_vector_type(16)));
#define MFMA32(a, b, c) __builtin_amdgcn_mfma_f32_32x32x16_bf16((a), (b), (c), 0, 0, 0)
constexpr int SSD_XT = 0, SSD_BN = 66560, SSD_CN = SSD_BN + 16384, SSD_CS = SSD_CN + 16384, SSD_DT = SSD_CS + 4096, SSD_W = SSD_DT + 4096, SSD_PV = SSD_W + 4096;
static_assert(SSD_PV + 32768 <= 147456 - 16, "SSD LDS map");
constexpr int YL_STRIDE = 520;
__device__ __forceinline__ int fsw(int row) { return (row ^ (row >> 3)) & 15; }
__device__ __forceinline__ int crow(int reg, int hh) { return (reg & 3) + 8 * (reg >> 2) + 4 * hh; }
__device__ __forceinline__ bf16x8 pack8(float a0, float a1, float a2, float a3, float a4, float a5, float a6, float a7) {
    return __builtin_bit_cast(bf16x8, (u32x4){pk2(a0, a1), pk2(a2, a3), pk2(a4, a5), pk2(a6, a7)});
}
template <int MODE> __device__ __forceinline__ void ssd_tables(const Params& P, LAS unsigned char* lds, int ci, const int wv) {
    const int tid = tid_from(wv), lane = tid & 63, h = __builtin_amdgcn_readfirstlane(tid >> 6);
    const float* dtg = (const float*)(P.ws + WS_DT); const size_t t0 = (size_t)ci * 128;
    const float a2 = -__expf(P.in[8][h]) * LOG2E;
    const float d0 = dtg[(t0 + lane) * 8 + h], d1 = dtg[(t0 + 64 + lane) * 8 + h];
    float s0 = d0 * a2, s1 = d1 * a2;
#pragma unroll
    for (int o = 1; o < 64; o <<= 1) { const float u0 = __shfl_up(s0, o), u1 = __shfl_up(s1, o); if (lane >= o) { s0 += u0; s1 += u1; } }
    s1 += __shfl(s0, 63); const float last = __shfl(s1, 63);
    LAS float* cs = (LAS float*)(lds + SSD_CS) + h * 128; LAS float* dv = (LAS float*)(lds + SSD_DT) + h * 128; LAS float* wtab = (LAS float*)(lds + SSD_W) + h * 128;
    cs[lane] = s0; cs[lane + 64] = s1; dv[lane] = d0; dv[lane + 64] = d1;
    if (MODE == 1) { wtab[lane] = d0 * __builtin_amdgcn_exp2f(last - s0); wtab[lane + 64] = d1 * __builtin_amdgcn_exp2f(last - s1);
        if (lane == 0) ((float*)(P.ws + WS_CDEC))[ci * 8 + h] = __builtin_amdgcn_exp2f(last); }
    else { wtab[lane] = __builtin_amdgcn_exp2f(s0); wtab[lane + 64] = __builtin_amdgcn_exp2f(s1); }
}
template <bool TR> __device__ __forceinline__ void conv_task(const bf16_t* proj, size_t t0, int l0, int col, bool seq_start, const float* cw, const float* cb, int chw, const float (&sc)[8], u32x4 (&out)[8]) {
    u32x4 raw[11];
#pragma unroll
    for (int i = 0; i < 11; ++i) { const int row = l0 - 3 + i; if (seq_start && row < 0) raw[i] = (u32x4){0u, 0u, 0u, 0u}; else raw[i] = *(const u32x4*)(proj + (size_t)((long)t0 + row) * NPROJ + col); }
    f32x4 w[4][2];
#pragma unroll
    for (int k = 0; k < 4; ++k) { w[k][0] = *(const f32x4*)(cw + k * 768 + chw); w[k][1] = *(const f32x4*)(cw + k * 768 + chw + 4); }
    const f32x4 b0 = *(const f32x4*)(cb + chw), b1 = *(const f32x4*)(cb + chw + 4);
#pragma unroll
    for (int q = 0; q < 4; ++q) {
        float oa[8], ob[8];
        const float ba = (q < 2) ? b0[2 * (q & 1)] : b1[2 * (q & 1)], bb = (q < 2) ? b0[2 * (q & 1) + 1] : b1[2 * (q & 1) + 1];
#pragma unroll
        for (int i = 0; i < 8; ++i) { float a = ba, b = bb;
#pragma unroll
            for (int k = 0; k < 4; ++k) { const unsigned wd = raw[i + k][q]; a += w[k][q >> 1][2 * (q & 1)] * bflo(wd); b += w[k][q >> 1][2 * (q & 1) + 1] * bfhi(wd); }
            oa[i] = siluf(a); ob[i] = siluf(b); }
        if (TR) {
            out[2 * q] = (u32x4){pk2(oa[0] * sc[0], oa[1] * sc[1]), pk2(oa[2] * sc[2], oa[3] * sc[3]), pk2(oa[4] * sc[4], oa[5] * sc[5]), pk2(oa[6] * sc[6], oa[7] * sc[7])};
            out[2 * q + 1] = (u32x4){pk2(ob[0] * sc[0], ob[1] * sc[1]), pk2(ob[2] * sc[2], ob[3] * sc[3]), pk2(ob[4] * sc[4], ob[5] * sc[5]), pk2(ob[6] * sc[6], ob[7] * sc[7])};
        } else {
#pragma unroll
            for (int i = 0; i < 8; ++i) out[i][q] = pk2(oa[i], ob[i]);
        }
    }
}
__device__ __forceinline__ void s1_chunk(const Params& P, LAS unsigned char* lds, int ci, const int wv) {
    int tid_ = tid_from(wv); asm volatile("" : "+v"(tid_));
    const int tid = tid_, lane = tid & 63, wave = __builtin_amdgcn_readfirstlane(tid >> 6);
    const bf16_t* proj = (const bf16_t*)(P.ws + WS_PROJ); const size_t t0 = (size_t)ci * 128; const bool seq_start = (ci & 63) == 0;
    const float* cw = P.in[5]; const float* cb = P.in[6];
    ssd_tables<1>(P, lds, ci, wv);
    lds_barrier();
#pragma unroll 1
    for (int g = 0; g < 2; ++g) {
        { const int cg = tid & 31, run = tid >> 5, l0 = run * 8; u32x4 o[8];
            const LAS float* wvp = (const LAS float*)(lds + SSD_W) + (g * 4 + (cg >> 3)) * 128 + l0; const f32x4 w0 = *(const LAS f32x4*)wvp, w1 = *(const LAS f32x4*)(wvp + 4);
            const float sc[8] = {w0[0], w0[1], w0[2], w0[3], w1[0], w1[1], w1[2], w1[3]};
            conv_task<true>(proj, t0, l0, PC_XS + g * 256 + cg * 8, seq_start, cw, cb, g * 256 + cg * 8, sc, o);
#pragma unroll
            for (int j = 0; j < 8; ++j) { const int row = cg * 8 + j; *(LAS u32x4*)(lds + SSD_XT + row * 256 + ((run ^ fsw(row)) * 16)) = o[j]; } }
        asm volatile("" ::: "memory");
        if (tid < 128) { const int cg = tid & 7, run = tid >> 3, l0 = run * 8; u32x4 o[8]; const float sc[8] = {1.f, 1.f, 1.f, 1.f, 1.f, 1.f, 1.f, 1.f};
            conv_task<true>(proj, t0, l0, PC_B + g * 64 + cg * 8, seq_start, cw, cb, 512 + g * 64 + cg * 8, sc, o);
#pragma unroll
            for (int j = 0; j < 8; ++j) { const int row = cg * 8 + j; *(LAS u32x4*)(lds + SSD_BN + row * 256 + ((run ^ fsw(row)) * 16)) = o[j]; } }
        lds_barrier();
        { const int hl = wave >> 1, pt = wave & 1, r = lane & 31, hh = lane >> 5; f32x16 acc[2];
#pragma unroll
            for (int i = 0; i < 16; ++i) { acc[0][i] = 0.f; acc[1][i] = 0.f; }
            const int arow = hl * 64 + 32 * pt + r, fa = fsw(arow);
#pragma unroll
            for (int ks = 0; ks < 8; ++ks) { const int ch = 2 * ks + hh; const bf16x8 a = *(const LAS bf16x8*)(lds + SSD_XT + arow * 256 + ((ch ^ fa) * 16));
#pragma unroll
                for (int nt = 0; nt < 2; ++nt) { const int brow = 32 * nt + r; const bf16x8 b = *(const LAS bf16x8*)(lds + SSD_BN + brow * 256 + ((ch ^ fsw(brow)) * 16)); acc[nt] = MFMA32(a, b, acc[nt]); } }
            float* st = (float*)(P.ws + WS_STATES) + (((size_t)ci * 8 + g * 4 + hl) * 64 + 32 * pt) * 64;
#pragma unroll
            for (int nt = 0; nt < 2; ++nt)
#pragma unroll
                for (int reg = 0; reg < 16; ++reg) st[crow(reg, hh) * 64 + 32 * nt + r] = acc[nt][reg]; }
        lds_barrier();
    }
}
__device__ __forceinline__ void s2_scan(const Params& P, int blk, int nblk, const int wv) {
    int tid_ = tid_from(wv); asm volatile("" : "+v"(tid_));
    const float* states = (const float*)(P.ws + WS_STATES); bf16_t* prevb = (bf16_t*)(P.ws + WS_PREV); const float* cdec = (const float*)(P.ws + WS_CDEC);
    for (int idx = blk * 512 + tid_; idx < 65536; idx += nblk * 512) {
        const int b = idx >> 13, rem = idx & 8191, h = rem >> 10, e = (rem & 1023) * 4;
        f32x4 carry = (f32x4){0.f, 0.f, 0.f, 0.f};
#pragma unroll 8
        for (int c = 0; c < 64; ++c) { const int ci = b * 64 + c; const size_t off = ((size_t)ci * 8 + h) * 4096 + e;
            const f32x4 sv = *(const f32x4*)(states + off); u32x2 o; o.x = pk2(carry[0], carry[1]); o.y = pk2(carry[2], carry[3]); *(u32x2*)(prevb + off) = o;
            carry = carry * cdec[ci * 8 + h] + sv; }
    }
}
__device__ __forceinline__ void s3_chunk(const Params& P, LAS unsigned char* lds, int ci, const int wv) {
    int tid_ = tid_from(wv); asm volatile("" : "+v"(tid_));
    int tid = tid_, lane = tid & 63; const int wave = __builtin_amdgcn_readfirstlane(tid >> 6);
    const bf16_t* proj = (const bf16_t*)(P.ws + WS_PROJ); bf16_t* ycat = (bf16_t*)(P.ws + WS_YCAT); const size_t t0 = (size_t)ci * 128; const bool seq_start = (ci & 63) == 0;
    const float* cw = P.in[5]; const float* cb = P.in[6];
    ssd_tables<3>(P, lds, ci, wv);
    u32x4 sra[6], srb[6], sgb[4];
#define SC_LOAD(qb) do { const int _cg = tid & 63, _l0 = (tid >> 6) * 16 + (qb) * 4; \
        _Pragma("unroll") for (int _i = 0; _i < 6; ++_i) { const int _row = _l0 - 2 + _i; \
            if (seq_start && _row < 0) { sra[_i] = (u32x4){0u, 0u, 0u, 0u}; srb[_i] = sra[_i]; } \
            else { const size_t _ro = (size_t)((long)t0 + _row) * NPROJ + _cg * 8; sra[_i] = *(const u32x4*)(proj + _ro + PC_GC); srb[_i] = *(const u32x4*)(proj + _ro + PC_V); } } \
        _Pragma("unroll") for (int _i = 0; _i < 4; ++_i) sgb[_i] = *(const u32x4*)(proj + (t0 + _l0 + _i) * NPROJ + PC_GB + _cg * 8); } while (0)
#define SC_COMPUTE(qb) do { const int _cg = tid & 63, _l0 = (tid >> 6) * 16 + (qb) * 4; const float* _sw = P.in[11]; f32x4 _w[3][2]; \
        _Pragma("unroll") for (int _k = 0; _k < 3; ++_k) { _w[_k][0] = *(const f32x4*)(_sw + _k * 512 + _cg * 8); _w[_k][1] = *(const f32x4*)(_sw + _k * 512 + _cg * 8 + 4); } \
        _Pragma("unroll") for (int _i = 0; _i < 4; ++_i) { u32x4 _o; \
            _Pragma("unroll") for (int _q = 0; _q < 4; ++_q) { float _a = 0.f, _b = 0.f; \
                _Pragma("unroll") for (int _k = 0; _k < 3; ++_k) { _a += _w[_k][_q >> 1][2 * (_q & 1)] * (bflo(sra[_i + _k][_q]) * bflo(srb[_i + _k][_q])); _b += _w[_k][_q >> 1][2 * (_q & 1) + 1] * (bfhi(sra[_i + _k][_q]) * bfhi(srb[_i + _k][_q])); } \
                _o[_q] = pk2(_a * bflo(sgb[_i][_q]), _b * bfhi(sgb[_i][_q])); } \
            *(u32x4*)(ycat + (t0 + _l0 + _i) * 1024 + 512 + _cg * 8) = _o; } } while (0)
    lds_barrier();
#pragma unroll 1
    for (int g = 0; g < 2; ++g) {
        asm volatile("" : "+v"(tid)); lane = tid & 63;
        SC_LOAD(2 * g);
        for (int rep_ = 0; rep_ < (PROBE_DUP == 31 ? 2 : 1); ++rep_) {
        { const int cg = tid & 31, run = tid >> 5, l0 = run * 8; u32x4 o[8]; const float sc[8] = {1.f, 1.f, 1.f, 1.f, 1.f, 1.f, 1.f, 1.f};
            conv_task<true>(proj, t0, l0, PC_XS + g * 256 + cg * 8, seq_start, cw, cb, g * 256 + cg * 8, sc, o);
            const bool sw4 = (cg >> 1) & 1;
#pragma unroll
            for (int j = 0; j < 8; ++j) { const int row = cg * 8 + j; u32x4 v; v.x = sw4 ? o[j].z : o[j].x; v.y = sw4 ? o[j].w : o[j].y; v.z = sw4 ? o[j].x : o[j].z; v.w = sw4 ? o[j].y : o[j].w;
                *(LAS u32x4*)(lds + SSD_XT + row * 256 + ((run ^ fsw(row)) * 16)) = v; } }
        asm volatile("" ::: "memory");
        if (tid < 256) { const int which = tid >> 7, cg = tid & 7, run = (tid >> 3) & 15, l0 = run * 8; u32x4 o[8]; const float sc[8] = {1.f, 1.f, 1.f, 1.f, 1.f, 1.f, 1.f, 1.f};
            conv_task<false>(proj, t0, l0, (which ? PC_C : PC_B) + g * 64 + cg * 8, seq_start, cw, cb, (which ? 640 : 512) + g * 64 + cg * 8, sc, o);
            LAS unsigned char* img = lds + (which ? SSD_CN : SSD_BN);
#pragma unroll
            for (int i = 0; i < 8; ++i) { const int row = l0 + i; *(LAS u32x4*)(img + row * 128 + ((cg ^ ((row >> 1) & 7)) * 16)) = o[i]; } }
        { const u32x4* pg = (const u32x4*)((const bf16_t*)(P.ws + WS_PREV) + ((size_t)ci * 8 + g * 4) * 4096);
#pragma unroll
            for (int i = 0; i < 4; ++i) { const int q = tid + 512 * i, row = q >> 3, chv = q & 7; *(LAS u32x4*)(lds + SSD_PV + row * 128 + ((chv ^ ((row >> 1) & 7)) * 16)) = pg[q]; } }
        if (rep_ == 0) { SC_COMPUTE(2 * g); SC_LOAD(2 * g + 1); }
        lds_barrier(); }
        const int hl = wave >> 1, half = wave & 1, hh = lane >> 5, h = g * 4 + hl; int r = lane & 31;
        f32x16 accs[2][2];
        for (int rep_ = 0; rep_ < (PROBE_DUP == 32 ? 2 : 1); ++rep_)
        {
            const float dsk = P.in[9][h];
            const LAS float* csT = (const LAS float*)(lds + SSD_CS) + h * 128; const LAS float* dtT = (const LAS float*)(lds + SSD_DT) + h * 128; const LAS float* exT = (const LAS float*)(lds + SSD_W) + h * 128;
            const int b4 = (r >> 4) & 1;
#pragma unroll
            for (int li = 0; li < 2; ++li) {
                if (li == 1) asm volatile("" : "+v"(r) : "v"(accs[0][0][0]), "v"(accs[0][1][0]));
                const int lt = half ? (li ? 2 : 1) : (li ? 3 : 0); const int l = 32 * lt + r;
                f32x16 a0, a1;
#pragma unroll
                for (int i = 0; i < 16; ++i) { a0[i] = 0.f; a1[i] = 0.f; }
                bf16x8 cf[4];
#pragma unroll
                for (int ks = 0; ks < 4; ++ks) cf[ks] = *(const LAS bf16x8*)(lds + SSD_CN + l * 128 + (((2 * ks + hh) ^ ((l >> 1) & 7)) * 16));
                const float csl = csT[l];
                for (int st = 0; st <= lt; ++st) {
                    f32x16 X;
#pragma unroll
                    for (int i = 0; i < 16; ++i) X[i] = 0.f;
                    const int srow = 32 * st + r;
#pragma unroll
                    for (int ks = 0; ks < 4; ++ks) { const bf16x8 bfr = *(const LAS bf16x8*)(lds + SSD_BN + srow * 128 + (((2 * ks + hh) ^ ((srow >> 1) & 7)) * 16)); X = MFMA32(bfr, cf[ks], X); }
                    const bool diag = (st == lt);
#pragma unroll
                    for (int q = 0; q < 4; ++q) { const int sb = 32 * st + 8 * q + 4 * hh; const f32x4 c4 = *(const LAS f32x4*)(csT + sb), d4 = *(const LAS f32x4*)(dtT + sb);
#pragma unroll
                        for (int i = 0; i < 4; ++i) { const int s = sb + i; float f = __builtin_amdgcn_exp2f(csl - c4[i]) * d4[i];
                            if (diag) f = (s <= l) ? f : 0.f;
                            float v = X[4 * q + i] * f; if (diag) v = (s == l) ? v + dsk : v; X[4 * q + i] = v; } }
                    const bf16x8 xb0 = pack8(X[0], X[1], X[2], X[3], X[4], X[5], X[6], X[7]), xb1 = pack8(X[8], X[9], X[10], X[11], X[12], X[13], X[14], X[15]);
#pragma unroll
                    for (int sp = 0; sp < 2; ++sp)
#pragma unroll
                        for (int pt = 0; pt < 2; ++pt) { const int row = hl * 64 + 32 * pt + r, ch = 4 * st + 2 * sp, fr_ = fsw(row);
                            const u32x2 p1 = *(const LAS u32x2*)(lds + SSD_XT + row * 256 + (((ch ^ fr_) * 2 + (hh ^ b4)) * 8)), p2 = *(const LAS u32x2*)(lds + SSD_XT + row * 256 + ((((ch + 1) ^ fr_) * 2 + (hh ^ b4)) * 8));
                            const bf16x8 af = __builtin_bit_cast(bf16x8, (u32x4){p1.x, p1.y, p2.x, p2.y});
                            if (pt == 0) a0 = MFMA32(af, sp ? xb1 : xb0, a0); else a1 = MFMA32(af, sp ? xb1 : xb0, a1); }
                }
                const float el = exT[l];
                bf16x8 pf[2][4];
#pragma unroll
                for (int pt = 0; pt < 2; ++pt)
#pragma unroll
                    for (int ks = 0; ks < 4; ++ks) { const int prow = hl * 64 + 32 * pt + r; pf[pt][ks] = *(const LAS bf16x8*)(lds + SSD_PV + prow * 128 + (((2 * ks + hh) ^ ((prow >> 1) & 7)) * 16)); }
#pragma unroll
                for (int ks = 0; ks < 4; ++ks) { const u32x4 cw4 = __builtin_bit_cast(u32x4, cf[ks]);
                    const bf16x8 cs_ = pack8(bflo(cw4.x) * el, bfhi(cw4.x) * el, bflo(cw4.y) * el, bfhi(cw4.y) * el, bflo(cw4.z) * el, bfhi(cw4.z) * el, bflo(cw4.w) * el, bfhi(cw4.w) * el);
                    a0 = MFMA32(pf[0][ks], cs_, a0); a1 = MFMA32(pf[1][ks], cs_, a1); }
                accs[li][0] = a0; accs[li][1] = a1;
            }
        }
        SC_COMPUTE(2 * g + 1);
        u32x4 zpre[8];
#pragma unroll
        for (int i = 0; i < 8; ++i) zpre[i] = *(const u32x4*)(proj + (t0 + (tid >> 5) + 16 * i) * NPROJ + PC_Z + g * 256 + (tid & 31) * 8);
        lds_barrier();
        for (int rep_ = 0; rep_ < (PROBE_DUP == 33 ? 2 : 1); ++rep_) {
#pragma unroll
        for (int li = 0; li < 2; ++li) { const int lt = half ? (li ? 2 : 1) : (li ? 3 : 0); const int l = 32 * lt + r;
#pragma unroll
            for (int pt = 0; pt < 2; ++pt)
#pragma unroll
                for (int q = 0; q < 4; ++q) { u32x2 o; o.x = cvt_pk_bf16(accs[li][pt][4 * q], accs[li][pt][4 * q + 1]); o.y = cvt_pk_bf16(accs[li][pt][4 * q + 2], accs[li][pt][4 * q + 3]);
                    *(LAS u32x2*)(lds + SSD_XT + l * YL_STRIDE + (hl * 64 + 32 * pt + 8 * q + 4 * hh) * 2) = o; } }
        lds_barrier();
        { const int cg = tid & 31;
#pragma unroll
            for (int i = 0; i < 8; ++i) { const int l = (tid >> 5) + 16 * i;
                const u32x2 y0 = *(const LAS u32x2*)(lds + SSD_XT + l * YL_STRIDE + cg * 16), y1 = *(const LAS u32x2*)(lds + SSD_XT + l * YL_STRIDE + cg * 16 + 8);
                const u32x4 z = zpre[i];
                const unsigned yw[4] = {y0.x, y0.y, y1.x, y1.y}; float v[8]; float q = 0.f;
#pragma unroll
                for (int k = 0; k < 4; ++k) { v[2 * k] = bflo(yw[k]) * siluf(bflo(z[k])); v[2 * k + 1] = bfhi(yw[k]) * siluf(bfhi(z[k])); q += v[2 * k] * v[2 * k] + v[2 * k + 1] * v[2 * k + 1]; }
                q = row16_sum(q); q += __shfl_xor(q, 16);
                const float rs = rsqrtf(q * (1.f / 256.f) + EPS);
                u32x4 o; o.x = pk2(v[0] * rs, v[1] * rs); o.y = pk2(v[2] * rs, v[3] * rs); o.z = pk2(v[4] * rs, v[5] * rs); o.w = pk2(v[6] * rs, v[7] * rs);
                *(u32x4*)(ycat + (t0 + l) * 1024 + g * 256 + cg * 8) = o; } }
        lds_barrier(); }
    }
}
#undef SC_LOAD
#undef SC_COMPUTE

#define XB_TMO      128
#define XB_XCNT(j)  (256  + 64 * (j))
#define XB_XSUB(j)  (1280 + 64 * (j))
#define XB_XGEN(j)  (2304 + 64 * (j))
#define XB_TOP      3328
#define XB_TOPGEN   3392
#define XCD_BAR_WORDS 3456
#define XB_SPIN_CAP (1u << 18)

__device__ __forceinline__ unsigned xb_ld(unsigned* p)              { return __hip_atomic_load(p, __ATOMIC_RELAXED, __HIP_MEMORY_SCOPE_AGENT); }
__device__ __forceinline__ unsigned xb_add(unsigned* p, unsigned v) { return __hip_atomic_fetch_add(p, v, __ATOMIC_RELAXED, __HIP_MEMORY_SCOPE_AGENT); }
__device__ __forceinline__ unsigned xb_xcc_id() { return (unsigned)__builtin_amdgcn_s_getreg((3 << 11) | 20) & 0xFu; }
#define XB_SPIN(cond, bar) do { unsigned _sp = 0; while (cond) { __builtin_amdgcn_s_sleep(1); \
    if ((++_sp & 255u) == 0u) { if (xb_ld(&(bar)[XB_TMO])) break; if (_sp > XB_SPIN_CAP) { atomicAdd(&(bar)[XB_TMO], 1u); break; } } } } while (0)

struct XcdBarrier {
    unsigned* bar; unsigned x;
    volatile LAS unsigned* st;
};

__device__ __forceinline__ XcdBarrier xcd_barrier_post(unsigned* bar, volatile LAS unsigned* st, const bool t0) {
    XcdBarrier b; b.bar = bar; b.x = xb_xcc_id(); b.st = st;
    if (t0) (void)xb_add(&bar[XB_XCNT(b.x)], 1u);
    return b;
}
__device__ __forceinline__ void xcd_barrier_complete(unsigned* bar, unsigned x, unsigned& nloc, unsigned& nx) {
    const unsigned G = gridDim.x * gridDim.y * gridDim.z;
    unsigned sum, cnt, mine, sp = 0u;
    for (;;) {
        sum = 0u; cnt = 0u; mine = 0u;
#pragma unroll
        for (unsigned j = 0; j < 16; ++j) { const unsigned c = xb_ld(&bar[XB_XCNT(j)]); sum += c; cnt += (c > 0u) ? 1u : 0u; mine = (j == x) ? c : mine; }
        if (sum == G) break;
        __builtin_amdgcn_s_sleep(1);
        if ((++sp & 255u) == 0u) { if (xb_ld(&bar[XB_TMO])) break; if (sp > XB_SPIN_CAP) { atomicAdd(&bar[XB_TMO], 1u); break; } }
    }
    nloc = mine > 0u ? mine : 1u; nx = cnt > 0u ? cnt : 1u;
}

__device__ __forceinline__ void xcd_barrier(const XcdBarrier& b, const bool t0) {
    asm volatile("s_waitcnt vmcnt(0)" ::: "memory");
    __syncthreads();
    if (t0) {
        unsigned* bar = b.bar;
        __builtin_amdgcn_s_waitcnt(0);
        unsigned nloc = b.st[0], nx = b.st[1];
        if (nloc == 0u) { xcd_barrier_complete(bar, b.x, nloc, nx); b.st[0] = nloc; b.st[1] = nx; }
        const unsigned old = xb_add(&bar[XB_XSUB(b.x)], 1u);
        const unsigned gen = old / nloc;
        if (old + 1u == (gen + 1u) * nloc) {
            __builtin_amdgcn_fence(__ATOMIC_RELEASE, "agent");
            asm volatile("s_waitcnt vmcnt(0)" ::: "memory");
            const unsigned og = xb_add(&bar[XB_TOP], 1u);
            const unsigned tg = og / nx;
            if (og + 1u == (tg + 1u) * nx) xb_add(&bar[XB_TOPGEN], 1u);
            else XB_SPIN(xb_ld(&bar[XB_TOPGEN]) == tg, bar);
            __builtin_amdgcn_fence(__ATOMIC_ACQUIRE, "agent");
            xb_add(&bar[XB_XGEN(b.x)], 1u);
            asm volatile("s_waitcnt vmcnt(0)" ::: "memory");
        } else {
            XB_SPIN(xb_ld(&bar[XB_XGEN(b.x)]) == gen, bar);
            __builtin_amdgcn_fence(__ATOMIC_ACQUIRE, "agent");
            asm volatile("s_waitcnt vmcnt(0)" ::: "memory");
        }
    }
    __syncthreads();
}


constexpr int RT_W = 0, RT_LOG = 0, RT_CNT = 98304, RT_BASE = RT_CNT + 1024;
__device__ __forceinline__ void m1_router(const Params& P, LAS unsigned char* lds, int blk, int nblk, const int wv, const XcdBarrier& bar) {
    int tid_ = tid_from(wv); asm volatile("" : "+v"(tid_));
    const int tid = tid_, lane = tid & 63, wave = __builtin_amdgcn_readfirstlane(tid >> 6), fr = lane & 15, fq = lane >> 4;
    unsigned char* ws = P.ws; const bf16_t* h2 = (const bf16_t*)(ws + WS_H2); const bf16_t* wr = (const bf16_t*)(ws + WS_WR);
    const float* ssq2 = (const float*)(ws + WS_SSQ2); unsigned* gcnt = (unsigned*)(ws + WS_CTL) + CW_CNT;
    int* lsrc = (int*)(ws + WS_LSRC); float* lrs = (float*)(ws + WS_LRS); int* tslot = (int*)(ws + WS_TSLOT); float* tcomb = (float*)(ws + WS_TSLOT + MiB);
    const float* b_rg = P.in[19]; const float* b_re = P.in[21];
    LAS int* lcnt = (LAS int*)(lds + RT_CNT); LAS int* lbase = (LAS int*)(lds + RT_BASE);
    { const int tile = blk;
        const int tb = tile * 256 + wave * 32;
        f32x4 acc[2][6];
#pragma unroll
        for (int a = 0; a < 2; ++a)
#pragma unroll
            for (int b = 0; b < 6; ++b) acc[a][b] = (f32x4){0.f, 0.f, 0.f, 0.f};
        bf16x8 ha[4][2], hb[4][2];
        const bf16_t* hrow = h2 + (size_t)(tb + fr) * 1024 + 8 * fq;
#define RT_LOADH(F, ks0) do { const bf16_t* _h = hrow + 32 * (ks0); _Pragma("unroll") for (int _q = 0; _q < 4; ++_q) _Pragma("unroll") for (int _m = 0; _m < 2; ++_m) F[_q][_m] = *(const bf16x8*)(_h + (size_t)_m * 16 * 1024 + 32 * _q); } while (0)
#define RT_MMAH(F, kl0) do { const LAS unsigned char* _w = lds + RT_W + fr * 1024; const int _c0 = 4 * (kl0) + fq; _Pragma("unroll") for (int _q = 0; _q < 4; ++_q) { bf16x8 wf[6]; \
            _Pragma("unroll") for (int _n = 0; _n < 6; ++_n) wf[_n] = *(const LAS bf16x8*)(_w + _n * 16384 + (((_c0 + 4 * _q) ^ fr) * 16)); \
            _Pragma("unroll") for (int _m = 0; _m < 2; ++_m) _Pragma("unroll") for (int _n = 0; _n < 6; ++_n) acc[_m][_n] = __builtin_amdgcn_mfma_f32_16x16x32_bf16(wf[_n], F[_q][_m], acc[_m][_n], 0, 0, 0); } } while (0)
#define RT_COPYW(half) do { __syncthreads();   \
            const u32x4* src = (const u32x4*)wr; \
            _Pragma("unroll") for (int i = 0; i < 12; ++i) { const int q = tid + 512 * i, row = q >> 6, ch = q & 63; *(LAS u32x4*)(lds + RT_W + row * 1024 + ((ch ^ (row & 15)) * 16)) = src[row * 128 + (half) * 64 + ch]; } \
            __syncthreads(); } while (0)
        RT_LOADH(ha, 0);
#pragma unroll 1
        for (int half = 0; half < 2; ++half) {
            RT_COPYW(half);
#pragma unroll 1
            for (int g = 0; g < 2; ++g) { const int ks = half * 16 + g * 8;
                RT_LOADH(hb, ks + 4); RT_MMAH(ha, g * 8);
                if (ks + 8 < 32) RT_LOADH(ha, ks + 8);
                RT_MMAH(hb, g * 8 + 4); } }
#undef RT_COPYW
#undef RT_LOADH
#undef RT_MMAH
        __syncthreads();
        LAS float* lt = (LAS float*)(lds + RT_LOG) + wave * 32 * 48;
#pragma unroll
        for (int mt = 0; mt < 2; ++mt)
#pragma unroll
            for (int gp = 0; gp < 3; ++gp) *(LAS f32x4*)(lt + (16 * mt + fr) * 48 + 16 * gp + 4 * fq) = acc[mt][2 * gp] + acc[mt][2 * gp + 1];
        __syncthreads();
        int e1 = 0, e2 = 0, r1 = 0, r2 = 0; float c1 = 0.f, c2 = 0.f, rstd_t = 0.f; const int t = tb + lane;
        if (lane < 32) {
            const f32x4 p = *(const f32x4*)(ssq2 + (size_t)t * 4); const float rstd = rsqrtf(((p[0] + p[1]) + (p[2] + p[3])) * (1.f / 1024.f) + EPS);
            rstd_t = rstd;
            const LAS float* row = lt + lane * 48; const f32x4 g4 = *(const LAS f32x4*)row;
            float gl[4]; int gi = 0;
#pragma unroll
            for (int j = 0; j < 4; ++j) gl[j] = g4[j] * rstd + b_rg[j];
#pragma unroll
            for (int j = 1; j < 4; ++j) if (gl[j] > gl[gi]) gi = j;
            float gs = 0.f;
#pragma unroll
            for (int j = 0; j < 4; ++j) gs += __expf(gl[j] - gl[gi]);
            const float gw = 1.f / gs;
            const f32x4 ea = *(const LAS f32x4*)(row + 4 + gi * 8), eb = *(const LAS f32x4*)(row + 8 + gi * 8);
            const f32x4 ba = *(const f32x4*)(b_re + gi * 8), bb = *(const f32x4*)(b_re + gi * 8 + 4);
            float el[8];
#pragma unroll
            for (int j = 0; j < 4; ++j) { el[j] = ea[j] * rstd + ba[j]; el[4 + j] = eb[j] * rstd + bb[j]; }
            int i1 = 0;
#pragma unroll
            for (int j = 1; j < 8; ++j) if (el[j] > el[i1]) i1 = j;
            int i2 = (i1 == 0) ? 1 : 0;
#pragma unroll
            for (int j = 0; j < 8; ++j) if (j != i1 && el[j] > el[i2]) i2 = j;
            float v1 = el[0], v2 = el[0];
#pragma unroll
            for (int j = 1; j < 8; ++j) { v1 = (i1 == j) ? el[j] : v1; v2 = (i2 == j) ? el[j] : v2; }
            const float w1 = 1.f / (1.f + __expf(v2 - v1));
            c1 = gw * w1; c2 = gw * (1.f - w1); e1 = gi * 8 + i1; e2 = gi * 8 + i2;
        }
        const bool act = lane < 32;
#pragma unroll 1
        for (int e = 0; e < NEXP; ++e) { const unsigned long long m1 = __ballot(act && e1 == e), m2 = __ballot(act && e2 == e); const unsigned long long below = (1ull << lane) - 1ull;
            if (act && e1 == e) r1 = __popcll(m1 & below);
            if (act && e2 == e) r2 = __popcll(m2 & below);
            if (lane == 0) lcnt[wave * 32 + e] = __popcll(m1) | (__popcll(m2) << 16); }
        __syncthreads();
        unsigned* gtc = (unsigned*)(ws + WS_CTL) + CW_TCNT;
        if (tid < 32) { int run = 0;
#pragma unroll
            for (int w = 0; w < 8; ++w) { const int v = lcnt[w * 32 + tid]; lbase[64 + w * 32 + tid] = run; run += (v & 0xffff) + (v >> 16); }
            __hip_atomic_store(gtc + tile * 32 + tid, (unsigned)run, __ATOMIC_RELAXED, __HIP_MEMORY_SCOPE_AGENT); atomicAdd(gcnt + tid, (unsigned)run); }
        xcd_barrier(bar, tid == 0);
        { const int e = tid & 31, part = tid >> 5; int s_ = 0;
            for (int t2 = part; t2 < tile; t2 += 16) s_ += (int)__hip_atomic_load(gtc + t2 * 32 + e, __ATOMIC_RELAXED, __HIP_MEMORY_SCOPE_AGENT);
            lbase[320 + part * 32 + e] = s_; }
        __syncthreads();
        if (tid < 32) { int s_ = 0;
#pragma unroll
            for (int q = 0; q < 16; ++q) s_ += lbase[320 + q * 32 + tid];
            lbase[tid] = s_; }
        __syncthreads();
        if (act) { const int q1 = lbase[e1] + lbase[64 + wave * 32 + e1] + r1, q2 = lbase[e2] + lbase[64 + wave * 32 + e2] + (lcnt[wave * 32 + e2] & 0xffff) + r2;
            const size_t p1 = (size_t)e1 * T + q1, p2 = (size_t)e2 * T + q2;
            lsrc[p1] = t; lrs[p1] = rstd_t; lsrc[p2] = t; lrs[p2] = rstd_t;
            *(int2*)(tslot + 2 * (size_t)t) = make_int2((e1 << 16) | q1, (e2 << 16) | q2); *(float2*)(tcomb + 2 * (size_t)t) = make_float2(c1, c2); }
    }
}
__device__ __forceinline__ void m5_final(const Params& P, LAS unsigned char* lds, int vcu, int ngw, const int wv) {
    moe_build_table(lds, (const unsigned*)(P.ws + WS_CTL), wv);
    const LAS int* tst = (const LAS int*)(lds + pg8::STAGE_BYTES + 4096);
    int tid_ = tid_from(wv); asm volatile("" : "+v"(tid_));
    const int lane = tid_ & 63, gw = vcu * 8 + (tid_ >> 6); const bf16_t* h2 = (const bf16_t*)(P.ws + WS_H2); const unsigned char* Y = (const unsigned char*)(P.ws + WS_Y); const float* g = P.in[25]; float* out = P.out;
    const int* tslot = (const int*)(P.ws + WS_TSLOT); const float* tcomb = (const float*)(P.ws + WS_TSLOT + MiB);
    f32x4 gg[4];
#pragma unroll
    for (int j = 0; j < 4; ++j) gg[j] = *(const f32x4*)(g + lane * 16 + 4 * j);
    for (int w0 = gw * 2; w0 < T; w0 += ngw * 2) {
        const int slv = __hip_atomic_load(tslot + 2 * (size_t)w0 + (lane & 3), __ATOMIC_RELAXED, __HIP_MEMORY_SCOPE_AGENT);
        const float cmv = __hip_atomic_load(tcomb + 2 * (size_t)w0 + (lane & 3), __ATOMIC_RELAXED, __HIP_MEMORY_SCOPE_AGENT);
        int sv[4]; f32x4 cm; size_t yrow[4];
#pragma unroll
        for (int q = 0; q < 4; ++q) { sv[q] = __builtin_amdgcn_readlane(slv, q); cm[q] = __builtin_bit_cast(float, __builtin_amdgcn_readlane(__builtin_bit_cast(int, cmv), q)) * (1.f / 16.f); }
#pragma unroll
        for (int q = 0; q < 4; ++q) yrow[q] = ((size_t)tst[sv[q] >> 16] * 256 + (sv[q] & 0xffff)) * 1024;
        u32x4 ra[2][2], rb[2], rc[2];
#pragma unroll
        for (int t = 0; t < 2; ++t) { const bf16_t* hr = h2 + (size_t)(w0 + t) * 1024 + lane * 16; ra[t][0] = *(const u32x4*)hr; ra[t][1] = *(const u32x4*)(hr + 8);
            rb[t] = *(const u32x4*)(Y + yrow[2 * t] + lane * 16); rc[t] = *(const u32x4*)(Y + yrow[2 * t + 1] + lane * 16); }
#pragma unroll
        for (int t = 0; t < 2; ++t) { float v[16]; float s = 0.f; const float c0 = cm[2 * t], c1 = cm[2 * t + 1];
#pragma unroll
            for (int q = 0; q < 4; ++q) { const f32x2 b0 = __builtin_amdgcn_cvt_pk_f32_fp8((int)rb[t][q], false), b1 = __builtin_amdgcn_cvt_pk_f32_fp8((int)rb[t][q], true);
                const f32x2 d0 = __builtin_amdgcn_cvt_pk_f32_fp8((int)rc[t][q], false), d1 = __builtin_amdgcn_cvt_pk_f32_fp8((int)rc[t][q], true);
                const unsigned h0 = ra[t][q >> 1][2 * (q & 1)], h1 = ra[t][q >> 1][2 * (q & 1) + 1];
                v[4 * q] = bflo(h0) + c0 * b0[0] + c1 * d0[0]; v[4 * q + 1] = bfhi(h0) + c0 * b0[1] + c1 * d0[1]; v[4 * q + 2] = bflo(h1) + c0 * b1[0] + c1 * d1[0]; v[4 * q + 3] = bfhi(h1) + c0 * b1[1] + c1 * d1[1]; }
#pragma unroll
            for (int q = 0; q < 16; ++q) s += v[q] * v[q];
            s = wave_sum(s); const float r = rsqrtf(s * (1.f / 1024.f) + EPS);
            float* orow = out + (size_t)(w0 + t) * 1024 + lane * 16;
#pragma unroll
            for (int j = 0; j < 4; ++j) *(f32x4*)(orow + 4 * j) = (f32x4){v[4 * j] * r * gg[j][0], v[4 * j + 1] * r * gg[j][1], v[4 * j + 2] * r * gg[j][2], v[4 * j + 3] * r * gg[j][3]}; }
    }
}

constexpr int LDS_BYTES = 147456;
__device__ __forceinline__ int vcu_of(int bx, int G) { return (G % 8 == 0) ? (bx % 8) * (G / 8) + bx / 8 : bx; }

enum { PH_P0 = 0, PH_INPROJ, PH_OUTPROJ, PH_KV, PH_FOLD, PH_S, PH_O, PH_GATEUP, PH_DOWN, PH_S1, PH_S2, PH_S3, PH_M1, PH_M5 };

template <int PH> __device__ __forceinline__ void run_phase(const Params& P, LAS unsigned char* lds, const int G, const int c, const int wv) {
    unsigned char* ws = P.ws;
    if constexpr (PH == PH_P0) { p0_prologue(P, lds, vcu_of(c, G), G, wv); }
    if constexpr (PH == PH_S1) { for (int ci = c; ci < 512; ci += G) s1_chunk(P, lds, ci, wv); }
    if constexpr (PH == PH_S2) { s2_scan(P, c, G, wv); }
    if constexpr (PH == PH_S3) { for (int ci = c; ci < 512; ci += G) s3_chunk(P, lds, ci, wv); }

    if constexpr (PH == PH_M5) { m5_final(P, lds, vcu_of(c, G), G * 8, wv); }
    if constexpr (PH == PH_INPROJ) {
        pg8::PlainSched S; S.lda = 1024; S.A = (const char*)(ws + WS_A); S.B = (const char*)(ws + WS_WIN); S.C = (char*)(ws + WS_PROJ); S.ldb = 1024; S.ldc = NPROJ; S.esz = 2; S.nM = T / 256; S.nN = NPROJ / 256; S.G = G; S.c = c; S.bper = 0; S.bstride = 0;
        EpiRowScale E{(const float*)(ws + WS_RSTDX), NPROJ};
        if (PROBE_DUP == 41) { S.kdup = 2; E.mul = 0.5f; }
        if (PROBE_DUP == 40) S.edup = 1;
        pg8::gemm_phase(lds, 1024, S, E, wv);
    }
    if constexpr (PH == PH_OUTPROJ) {
        pg8::PlainSched S; S.lda = 1024; S.A = (const char*)(ws + WS_YCAT); S.B = (const char*)(ws + WS_WOUT); S.C = (char*)(ws + WS_H1); S.ldb = 1024; S.ldc = 1024; S.esz = 2; S.nM = T / 256; S.nN = 4; S.G = G; S.c = c; S.bper = 0; S.bstride = 0;
        EpiResid E{(const bf16_t*)(ws + WS_A), (float*)(ws + WS_SSQ1), ATT_S_F8 ? (unsigned char*)(ws + WS_H2F8) : nullptr};
        pg8::gemm_phase(lds, 1024, S, E, wv);
    }
    if constexpr (PH == PH_KV) {
        pg8::PlainSched S; S.lda = 1024; S.A = (const char*)(ws + WS_MEMB); S.B = (const char*)(ws + WS_WKV); S.C = (char*)(ws + WS_KV); S.ldb = 1024; S.ldc = 2048; S.esz = 2; S.nM = NMEM / 256; S.nN = 8; S.G = G; S.c = c; S.bper = 0; S.bstride = 0;
        EpiRowScale E{(const float*)(ws + WS_RSTDM), 2048};
        pg8::gemm_phase(lds, 1024, S, E, wv);
    }
    if constexpr (PH == PH_FOLD) {
        EpiRowScale E{nullptr, 1024};
        if (ATT_O_F8 && c >= 128) { E.f8out = true; E.mul = 8.f; }
        if (ATT_S_F8 && c < 128) { E.f8out = true; E.mul = 16.f; }
        FoldSched S; const bool m0 = c < 128; S.lda = m0 ? 2048 : 1024; S.ldb = m0 ? 1024 : 2048; S.kv = (const char*)(ws + WS_KV); S.wq = (const char*)(ws + WS_WQP); S.wo = (const char*)(ws + WS_WO);
        S.mt = (char*)(ws + WS_MT); S.nt = (char*)(ws + WS_NT); S.G = G; S.c = c;
        pg8::gemm_phase(lds, 256, S, E, wv);
    }
    if constexpr (PH == PH_S) {
        EpiSoftmax E{(const float*)(ws + WS_SSQ1)};
        if constexpr (ATT_S_F8) {
            pg8::PlainSched8<123, 127> S; S.lda = 1024; S.A = (const char*)(ws + WS_H2F8); S.B = (const char*)(ws + WS_MT); S.C = (char*)(ws + WS_A); S.ldb = 1024; S.ldc = 1024; S.esz = ATT_O_F8 ? 1 : 2; S.nM = T / 256; S.nN = 4; S.G = G; S.c = c; S.bper = 32; S.bstride = (size_t)1024 * 1024;
            pg8::gemm_phase(lds, 1024, S, E, wv);
        } else {
            pg8::PlainSched S; S.lda = 1024; S.A = (const char*)(ws + WS_H1); S.B = (const char*)(ws + WS_MT); S.C = (char*)(ws + WS_A); S.ldb = 1024; S.ldc = 1024; S.esz = ATT_O_F8 ? 1 : 2; S.nM = T / 256; S.nN = 4; S.G = G; S.c = c; S.bper = 32; S.bstride = (size_t)1024 * 1024 * 2;
            pg8::gemm_phase(lds, 1024, S, E, wv);
        }
    }
    if constexpr (PH == PH_O) {
        EpiResid E{(const bf16_t*)(ws + WS_H1), (float*)(ws + WS_SSQ2), MOE_GU_F8 ? (unsigned char*)(ws + WS_H2F8) : nullptr};
        if constexpr (ATT_O_F8) {
            pg8::PlainSched8<124, 119> S; S.lda = 1024; S.A = (const char*)(ws + WS_A); S.B = (const char*)(ws + WS_NT); S.C = (char*)(ws + WS_H2); S.ldb = 1024; S.ldc = 1024; S.esz = 2; S.nM = T / 256; S.nN = 4; S.G = G; S.c = c; S.bper = 32; S.bstride = (size_t)1024 * 1024;
            pg8::gemm_phase(lds, 1024, S, E, wv);
        } else {
            pg8::PlainSched S; S.lda = 1024; S.A = (const char*)(ws + WS_A); S.B = (const char*)(ws + WS_NT); S.C = (char*)(ws + WS_H2); S.ldb = 1024; S.ldc = 1024; S.esz = 2; S.nM = T / 256; S.nN = 4; S.G = G; S.c = c; S.bper = 32; S.bstride = (size_t)1024 * 1024 * 2;
            pg8::gemm_phase(lds, 1024, S, E, wv);
        }
    }
    if constexpr (PH == PH_GATEUP) {
        moe_build_table(lds, (const unsigned*)(ws + WS_CTL), wv);
        GateUpSched S; S.hb = (const char*)(ws + (MOE_GU_F8 ? WS_H2F8 : WS_H2)); S.wgu = (const char*)(ws + WS_WGU); S.hbuf = (char*)(ws + WS_HBUF); S.lsrc = (const int*)(ws + WS_LSRC); S.tb.t = (const LAS int*)(lds + pg8::STAGE_BYTES + 4096); S.ldb = 1024; S.G = G; S.c = c;
        EpiSwiGLU E{(const float*)(ws + WS_LRS)};
        pg8::gemm_phase(lds, 1024, S, E, wv);
    }
    if constexpr (PH == PH_DOWN) {
        moe_build_table(lds, (const unsigned*)(ws + WS_CTL), wv);
        DownSched S; S.lda = DEXP; S.hbuf = (const char*)(ws + WS_HBUF); S.wd = (const char*)(ws + WS_WD); S.ysort = (char*)(ws + WS_Y); S.tb.t = (const LAS int*)(lds + pg8::STAGE_BYTES + 4096); S.ldb = DEXP; S.G = G; S.c = c;
        EpiRowScale E{nullptr, 1024}; E.f8out = true; E.mul = 16.f;
        pg8::gemm_phase(lds, DEXP, S, E, wv);
    }
}
constexpr int CW_BAR = 4096;
#if !defined(MULTI_LAUNCH)
__global__ void __launch_bounds__(512, 2) k_mega(Params P) {
    extern __shared__ __attribute__((aligned(16))) unsigned char lds_raw[];
    LAS unsigned char* lds = (LAS unsigned char*)lds_raw;
    const int G = gridDim.x, c = blockIdx.x, wv = __builtin_amdgcn_readfirstlane(threadIdx.x >> 6);
    if (tid_from(wv) == 0) *(LAS u32x4*)(lds + LDS_BYTES - 16) = (u32x4){0u, 0u, 0u, 0u};
    __syncthreads();
    const XcdBarrier bar = xcd_barrier_post((unsigned*)(P.ws + WS_CTL) + CW_BAR, (volatile LAS unsigned*)(lds + LDS_BYTES - 16), tid_from(wv) == 0);
#define PH_RUN(id, ...) do { __VA_ARGS__; if (PROBE_DUP == (id)) { xcd_barrier(bar, tid_from(wv) == 0); __VA_ARGS__; } } while (0)
    PH_RUN(0, run_phase<PH_P0>(P, lds, G, c, wv));      xcd_barrier(bar, tid_from(wv) == 0);
    PH_RUN(1, run_phase<PH_INPROJ>(P, lds, G, c, wv));  xcd_barrier(bar, tid_from(wv) == 0);
    PH_RUN(2, run_phase<PH_S1>(P, lds, G, c, wv));      xcd_barrier(bar, tid_from(wv) == 0);
    PH_RUN(3, if (c < 64) run_phase<PH_KV>(P, lds, 64, c, wv); else s2_scan(P, c - 64, G - 64, wv));
    xcd_barrier(bar, tid_from(wv) == 0);
    PH_RUN(4, run_phase<PH_FOLD>(P, lds, G, c, wv); run_phase<PH_S3>(P, lds, G, c, wv));      xcd_barrier(bar, tid_from(wv) == 0);
    PH_RUN(5, run_phase<PH_OUTPROJ>(P, lds, G, c, wv)); xcd_barrier(bar, tid_from(wv) == 0);
    PH_RUN(6, run_phase<PH_S>(P, lds, G, c, wv));       xcd_barrier(bar, tid_from(wv) == 0);
    PH_RUN(7, run_phase<PH_O>(P, lds, G, c, wv));       xcd_barrier(bar, tid_from(wv) == 0);
    m1_router(P, lds, c, G, wv, bar);    xcd_barrier(bar, tid_from(wv) == 0);
    PH_RUN(9, run_phase<PH_GATEUP>(P, lds, G, c, wv));  xcd_barrier(bar, tid_from(wv) == 0);
    PH_RUN(10, run_phase<PH_DOWN>(P, lds, G, c, wv));    xcd_barrier(bar, tid_from(wv) == 0);
    PH_RUN(11, run_phase<PH_M5>(P, lds, G, c, wv));
    if (PROBE_DUP == 12) { for (int i = 0; i < 8; ++i) xcd_barrier(bar, tid_from(wv) == 0); }
    if (PROBE_DUP == 20) { xcd_barrier(bar, tid_from(wv) == 0); p0_prologue(P, lds, vcu_of(c, G), G, wv, 1); }
    if (PROBE_DUP == 21) { xcd_barrier(bar, tid_from(wv) == 0); p0_prologue(P, lds, vcu_of(c, G), G, wv, 2); }
#undef PH_RUN
}
#else
template <int PH> __global__ void __launch_bounds__(512, 2) k_phase(Params P) {
    extern __shared__ __attribute__((aligned(16))) unsigned char lds_raw[];
    run_phase<PH>(P, (LAS unsigned char*)lds_raw, gridDim.x, blockIdx.x, __builtin_amdgcn_readfirstlane(threadIdx.x >> 6));
}
#endif

#if defined(MULTI_LAUNCH)
template <int PH> static void launch_phase(const Params& P, int grid, hipStream_t stream) {
    static bool attr = false;
    if (!attr) { (void)hipFuncSetAttribute((const void*)k_phase<PH>, hipFuncAttributeMaxDynamicSharedMemorySize, LDS_BYTES); attr = true; }
    hipLaunchKernelGGL(k_phase<PH>, dim3(grid), dim3(512), LDS_BYTES, stream, P);
}
#endif
extern "C" void kernel_launch(void* const* d_in, const int* in_sizes, int n_in, void* d_out, int out_size, void* d_ws, size_t ws_size, hipStream_t stream) {
    if (n_in != 26 || out_size != T * D || ws_size < WS_END) { fprintf(stderr, "kernel_launch: unexpected shapes (n_in %d out %d ws %zu)\n", n_in, out_size, ws_size); return; }
    const int grid = 256;
    Params P{};
    for (int i = 0; i < 26; ++i) P.in[i] = (const float*)d_in[i];
    P.out = (float*)d_out; P.ws = (unsigned char*)d_ws;
    (void)hipMemsetAsync(P.ws + WS_CTL, 0, CTL_BYTES, stream);
#if !defined(MULTI_LAUNCH)
    static bool attr = false;
    if (!attr) { (void)hipFuncSetAttribute((const void*)k_mega, hipFuncAttributeMaxDynamicSharedMemorySize, LDS_BYTES); attr = true; }
    hipLaunchKernelGGL(k_mega, dim3(grid), dim3(512), LDS_BYTES, stream, P);
#else
    launch_phase<PH_P0>(P, grid, stream);
    launch_phase<PH_INPROJ>(P, grid, stream);
    launch_phase<PH_S1>(P, grid, stream);
    launch_phase<PH_S2>(P, grid, stream);
    launch_phase<PH_KV>(P, grid, stream);
    launch_phase<PH_FOLD>(P, grid, stream);
    launch_phase<PH_S3>(P, grid, stream);
    launch_phase<PH_OUTPROJ>(P, grid, stream);
    launch_phase<PH_S>(P, grid, stream);
    launch_phase<PH_O>(P, grid, stream);
    launch_phase<PH_GATEUP>(P, grid, stream);
    launch_phase<PH_DOWN>(P, grid, stream);
    launch_phase<PH_M5>(P, grid, stream);
#endif
}
```

```cpp
#include <hip/hip_runtime.h>
#ifndef MOE_GU_F8
#define MOE_GU_F8 1
#endif
#ifndef MOE_DN_F8
#define MOE_DN_F8 1
#endif
#ifndef ATT_O_F8
#define ATT_O_F8 1
#endif
#ifndef ATT_S_F8
#define ATT_S_F8 1
#endif
#ifndef PROBE_DUP
#define PROBE_DUP -1
#endif
#include <cstdio>
#include <cstdint>

#define LAS __attribute__((address_space(3)))
typedef unsigned short bf16_t;
typedef short bf16x8 __attribute__((ext_vector_type(8)));
typedef float f32x4 __attribute__((ext_vector_type(4)));
typedef float f32x2 __attribute__((ext_vector_type(2)));
typedef unsigned u32x4 __attribute__((ext_vector_type(4)));
typedef unsigned u32x2 __attribute__((ext_vector_type(2)));
typedef int v8i __attribute__((ext_vector_type(8)));

constexpr int T = 65536, D = 1024, SEQ = 8192, NBATCH = 8, MEMLEN = 256, NMEM = NBATCH * MEMLEN;
constexpr int NPROJ = 2816;
constexpr int PC_Z = 0, PC_XS = 512, PC_B = 1024, PC_C = 1152, PC_GB = 1280, PC_GC = 1792, PC_V = 2304;
constexpr int INCOLS = 2824;
constexpr int NEXP = 32, DEXP = 512;
constexpr float EPS = 1e-6f;
constexpr float LOG2E = 1.4426950408889634f;

constexpr size_t MiB = 1u << 20;
constexpr size_t WS_CTL = 0, CTL_BYTES = 1 * MiB;
constexpr size_t WS_RSTDX = 1 * MiB;
constexpr size_t WS_RSTDM = WS_RSTDX + (size_t)T * 4;
constexpr size_t WS_DT = 2 * MiB;
constexpr size_t WS_SSQ1 = 4 * MiB;
constexpr size_t WS_SSQ2 = 5 * MiB;
constexpr size_t WS_ROUTE = 6 * MiB;
constexpr size_t WS_WIN = 8 * MiB;
constexpr size_t WS_WOUT = 14 * MiB;
constexpr size_t WS_WQP = 16 * MiB;
constexpr size_t WS_WKV = 18 * MiB;
constexpr size_t WS_WO = 22 * MiB;
constexpr size_t WS_WGU = 24 * MiB;
constexpr size_t WS_WD = 88 * MiB;
constexpr size_t WS_KV = 120 * MiB;
constexpr size_t WS_MT = 128 * MiB;
constexpr size_t WS_NT = 144 * MiB;
constexpr size_t WS_MEMB = 160 * MiB;
constexpr size_t WS_LSRC = 164 * MiB;
constexpr size_t WS_TSLOT = 172 * MiB;
constexpr size_t WS_LRS = 180 * MiB;
constexpr size_t WS_A = 192 * MiB;
constexpr size_t WS_H1 = 320 * MiB;
constexpr size_t WS_HBUF = 192 * MiB;
constexpr size_t WS_H2F8 = 720 * MiB;
constexpr size_t WS_PROJ = 448 * MiB;
constexpr size_t WS_Y = 448 * MiB;
constexpr size_t WS_SCORE = 448 * MiB;
constexpr size_t WS_H2 = 800 * MiB;
constexpr size_t WS_XC = 800 * MiB;
constexpr size_t WS_YRAW = 320 * MiB;
constexpr size_t WS_STATES = 800 * MiB;
constexpr size_t WS_PREV = 864 * MiB;
constexpr size_t WS_CDEC = 1 * MiB + 512 * 1024;
constexpr size_t WS_WR = 7 * MiB;
constexpr size_t WS_YCAT = 896 * MiB;
constexpr size_t WS_END = 1024 * MiB;
constexpr int CW_CNT = 64;
constexpr int CW_TCNT = 32768;

typedef __bf16 bf16v2 __attribute__((ext_vector_type(2)));
__device__ __forceinline__ unsigned pk2(float lo, float hi) { bf16v2 v; v[0] = (__bf16)lo; v[1] = (__bf16)hi; return __builtin_bit_cast(unsigned, v); }
__device__ __forceinline__ unsigned f2bf(float f) { return pk2(f, 0.f) & 0xffffu; }
__device__ __forceinline__ unsigned pk_fp8x4(float a, float b, float c, float d) { int w = 0; w = __builtin_amdgcn_cvt_pk_fp8_f32(a, b, w, false); w = __builtin_amdgcn_cvt_pk_fp8_f32(c, d, w, true); return (unsigned)w; }
__device__ __forceinline__ float bf2f(unsigned short b) { return __builtin_bit_cast(float, ((unsigned)b) << 16); }
__device__ __forceinline__ float bflo(unsigned w) { return __builtin_bit_cast(float, w << 16); }
__device__ __forceinline__ float bfhi(unsigned w) { return __builtin_bit_cast(float, w & 0xffff0000u); }
__device__ __forceinline__ float siluf(float v) { return v * __builtin_amdgcn_rcpf(1.f + __builtin_amdgcn_exp2f(v * -LOG2E)); }
#define DPP_ADD(v, ctrl, rmask) v += __builtin_bit_cast(float, __builtin_amdgcn_update_dpp(0, __builtin_bit_cast(int, v), (ctrl), (rmask), 0xF, true))
__device__ __forceinline__ float row16_sum(float v) { DPP_ADD(v, 0xB1, 0xF); DPP_ADD(v, 0x4E, 0xF); DPP_ADD(v, 0x141, 0xF); DPP_ADD(v, 0x140, 0xF); return v; }
__device__ __forceinline__ float wave_sum(float v) {
    v = row16_sum(v); DPP_ADD(v, 0x142, 0xA); DPP_ADD(v, 0x143, 0xC);
    return __builtin_bit_cast(float, __builtin_amdgcn_readlane(__builtin_bit_cast(int, v), 63));
}

__device__ __forceinline__ int tid_from(int wv) { int l; asm volatile("v_mbcnt_lo_u32_b32 %0, -1, 0\n\tv_mbcnt_hi_u32_b32 %0, -1, %0" : "=v"(l)); return (wv << 6) + l; }

namespace pg8 {
constexpr int BM = 256, BK = 64, HALF = 128, HTB = HALF * BK * 2, STAGE_BYTES = 8 * HTB, NXCD = 8, WGM = 8;
__host__ __device__ __forceinline__ int lds_byte(int r, int c) { const int st = (r >> 4) * 2 + (c >> 5), rr = r & 15, cc = c & 31, ob = rr * 64 + cc * 2; return st * 1024 + (ob ^ (((ob >> 9) & 1) << 5)); }
__host__ __device__ __forceinline__ void stage_rc(int b, int& R, int& C) { const int st = b / 1024, sb = b % 1024, swz = sb ^ (((sb >> 9) & 1) << 5); R = (st >> 1) * 16 + swz / 64; C = (st & 1) * 32 + (swz % 64) / 2; }
__host__ __device__ __forceinline__ int lds_byte8(int r, int fq) { return ((r >> 4) * 2 + (fq >> 1)) * 1024 + (r & 15) * 64 + 32 * ((fq & 1) ^ ((r >> 3) & 1)); }
__host__ __device__ __forceinline__ int perm32(int rho) { const int n = rho >> 4, i = rho & 15; return 8 * (i >> 2) + 4 * n + (i & 3); }

struct Unit { int pm, pn; const char* A; const char* B; char* C; int row0; int aux; };

__device__ __forceinline__ unsigned cvt_pk_bf16(float lo, float hi) { bf16v2 v; v[0] = (__bf16)lo; v[1] = (__bf16)hi; return __builtin_bit_cast(unsigned, v); }

__device__ __forceinline__ bool static_map(int i, int G, int c, int nM, int nN, int& pm, int& pn) {
    const int nwg = nM * nN; const long L = (long)i * G + c; if (L >= nwg) return false;
    int wgid = (int)L; { const int q = nwg / NXCD, r = nwg % NXCD, xcd = wgid % NXCD, off = wgid / NXCD; wgid = (xcd < r ? xcd * (q + 1) : r * (q + 1) + (xcd - r) * q) + off; }
    const int nig = WGM * nN, gid = wgid / nig, fm = gid * WGM, gsz = (nM - fm) < WGM ? (nM - fm) : WGM;
    pm = fm + ((wgid % nig) % gsz); pn = (wgid % nig) / gsz; return true;
}

template <class Epi, class Sched>
__device__ __forceinline__ void gemm_phase(LAS unsigned char* lds, const int K, const Sched& S, const Epi& E, const int wv) {
    int tid_ = tid_from(wv); asm volatile("" : "+v"(tid_));
    const int tid = tid_, wid = __builtin_amdgcn_readfirstlane(tid >> 6), lane = tid & 63, wr = wid >> 2, wc = wid & 3, fr = lane & 15, fq = lane >> 4;
    constexpr bool F8 = Sched::FP8;
    constexpr int ESZ = F8 ? 1 : 2;
    const int nt = K / (F8 ? 128 : BK);
    const int ldb = S.ldb;
    int Rr[2], Cc[2]; unsigned voffB[2], voffA0[2];
#pragma unroll
    for (int i = 0; i < 2; ++i) { int R, C; stage_rc(tid * 16 + i * 8192, R, C); Rr[i] = R; Cc[i] = C; const int Rb = Epi::PERM ? ((R & ~31) + perm32(R & 31)) : R; voffB[i] = (unsigned)(Rb * ldb * ESZ + C * 2);
        voffA0[i] = Sched::GATHER ? 0u : (unsigned)(R * S.lda_() * ESZ + C * 2); }
    const size_t kstep = (size_t)(BK * 2);
    const size_t hstepB = (size_t)HALF * ldb * ESZ;
    const size_t hstepA = Sched::GATHER ? 0 : (size_t)HALF * S.lda_() * ESZ;
    const unsigned ldsw = (unsigned)wid * 1024u;
    const int aoff = lds_byte(wr * 64 + fr, fq * 8), boff = lds_byte(wc * 32 + fr, fq * 8);
#define PG8_SA(b, h) (((b) * 2 + (h)) * HTB)
#define PG8_SB(b, h) ((4 + (b) * 2 + (h)) * HTB)
#define PG8_STAGE_B(bufoff, gbase) do { _Pragma("unroll") for (int _i = 0; _i < 2; ++_i) \
        __builtin_amdgcn_global_load_lds((const unsigned*)((const char*)(gbase) + voffB[_i]), (LAS unsigned*)(lds + (bufoff) + ldsw + _i * 8192), 16, 0, 0); } while (0)
#define PG8_STAGE_A(bufoff, gbase, VA, h) do { _Pragma("unroll") for (int _i = 0; _i < 2; ++_i) \
        __builtin_amdgcn_global_load_lds((const unsigned*)((const char*)(gbase) + (Sched::GATHER ? (size_t)(VA)[h][_i] : (size_t)(h) * hstepA + voffA0[_i])), (LAS unsigned*)(lds + (bufoff) + ldsw + _i * 8192), 16, 0, 0); } while (0)
struct Frag8 { bf16x8 lo, hi; };
#define PG8_RD8(base) ({ Frag8 _f; _f.lo = *(const LAS bf16x8*)(base); _f.hi = *(const LAS bf16x8*)((base) + 1024); __builtin_bit_cast(v8i, _f); })
#define PG8_LDA(dst, b, h) do { if constexpr (F8) { _Pragma("unroll") for (int m = 0; m < 4; ++m) dst##8[m] = PG8_RD8(lds + PG8_SA(b, h) + aoff + m * 2048); } \
        else { _Pragma("unroll") for (int m = 0; m < 4; ++m) _Pragma("unroll") for (int k = 0; k < 2; ++k) dst[m][k] = *(const LAS bf16x8*)(lds + PG8_SA(b, h) + aoff + m * 2048 + k * 1024); } } while (0)
#define PG8_LDB(dst, b, h) do { if constexpr (F8) { _Pragma("unroll") for (int n = 0; n < 2; ++n) dst##8[n] = PG8_RD8(lds + PG8_SB(b, h) + boff + n * 2048); } \
        else { _Pragma("unroll") for (int n = 0; n < 2; ++n) _Pragma("unroll") for (int k = 0; k < 2; ++k) dst[n][k] = *(const LAS bf16x8*)(lds + PG8_SB(b, h) + boff + n * 2048 + k * 1024); } } while (0)
#define PG8_MMA(ai, bj, At, Bt) do { __builtin_amdgcn_s_setprio(1); if constexpr (F8) { _Pragma("unroll") for (int m = 0; m < 4; ++m) _Pragma("unroll") for (int n = 0; n < 2; ++n) \
            asm volatile("v_mfma_scale_f32_16x16x128_f8f6f4 %0, %1, %2, %0, %3, %4 op_sel_hi:[0,0,0]" : "+v"(acc[ai][bj][m][n]) : "v"(Bt##8[n]), "v"(At##8[m]), "v"(scl_b), "v"(scl_a)); } \
        else { _Pragma("unroll") for (int m = 0; m < 4; ++m) _Pragma("unroll") for (int n = 0; n < 2; ++n) _Pragma("unroll") for (int k = 0; k < 2; ++k) \
            acc[ai][bj][m][n] = __builtin_amdgcn_mfma_f32_16x16x32_bf16(Bt[n][k], At[m][k], acc[ai][bj][m][n], 0, 0, 0); } __builtin_amdgcn_s_setprio(0); } while (0)
#define PG8_WAIT_V(n) asm volatile("s_waitcnt vmcnt(" #n ")" ::: "memory")
#define PG8_WAIT_L(n) asm volatile("s_waitcnt lgkmcnt(" #n ")" ::: "memory")
#define PG8_BAR __builtin_amdgcn_s_barrier()
#define PG8_SCHED __builtin_amdgcn_sched_barrier(0)
    Unit cur, nxt; int ui = 0;
    if (!S.next(0, cur)) return;
    f32x4 acc[2][2][4][2];
#pragma unroll
    for (int a = 0; a < 2; ++a)
#pragma unroll
        for (int b = 0; b < 2; ++b)
#pragma unroll
            for (int m = 0; m < 4; ++m)
#pragma unroll
                for (int n = 0; n < 2; ++n) acc[a][b][m][n] = (f32x4){0.f, 0.f, 0.f, 0.f};
    bf16x8 At[4][2], B0[2][2], B1[2][2]; v8i At8[4], B08[2], B18[2];
    int scl_a = Sched::SCALE_A, scl_b = Sched::SCALE_B; if constexpr (F8) asm volatile("" : "+v"(scl_a), "+v"(scl_b));
    unsigned vAc[2][2], vAn[2][2];
    if constexpr (Sched::GATHER) S.rows(cur, Rr, Cc, vAc);
    const char* cA = cur.A; const char* cB = cur.B;
    PG8_STAGE_B(PG8_SB(0, 0), cB); PG8_STAGE_B(PG8_SB(0, 1), cB + hstepB); PG8_STAGE_A(PG8_SA(0, 0), cA, vAc, 0); PG8_STAGE_A(PG8_SA(0, 1), cA, vAc, 1);
    if (wr == 1) PG8_BAR;
    PG8_WAIT_V(2); PG8_BAR;
    PG8_STAGE_B(PG8_SB(1, 0), cB + kstep); PG8_STAGE_A(PG8_SA(1, 0), cA + kstep, vAc, 0); PG8_STAGE_B(PG8_SB(1, 1), cB + hstepB + kstep);
    PG8_WAIT_V(6); PG8_BAR;
    for (;;) {
        const bool has_next = S.next(ui + 1, nxt);
        if constexpr (Sched::GATHER) { if (has_next) S.rows(nxt, Rr, Cc, vAn); else {
#pragma unroll
            for (int h = 0; h < 2; ++h)
#pragma unroll
                for (int i = 0; i < 2; ++i) vAn[h][i] = vAc[h][i]; } }
        const char* nA = has_next ? nxt.A : cA; const char* nB = has_next ? nxt.B : cB;
        const int kreps = S.kdup_();
#pragma unroll 1
        for (int krep = 0; krep < kreps; ++krep)
#pragma unroll 1
        for (int t = 0; t < nt; t += 2) {
            const bool last = (t == nt - 2) && (krep == kreps - 1);
            const char* a1 = cA + (size_t)(t + 1) * kstep;
            const char* a2 = last ? nA : ((t == nt - 2) ? cA : cA + (size_t)(t + 2) * kstep); const char* b2 = last ? nB : ((t == nt - 2) ? cB : cB + (size_t)(t + 2) * kstep);
            const char* a3 = a2 + kstep; const char* b3 = b2 + kstep;
            unsigned v2[2][2];
            if constexpr (Sched::GATHER) {
#pragma unroll
            for (int h = 0; h < 2; ++h)
#pragma unroll
                for (int i = 0; i < 2; ++i) v2[h][i] = last ? vAn[h][i] : vAc[h][i]; }
            PG8_LDB(B0, 0, 0); PG8_LDB(B1, 0, 1); PG8_SCHED; PG8_LDA(At, 0, 0); PG8_STAGE_A(PG8_SA(1, 1), a1, vAc, 1);
            PG8_WAIT_V(8); PG8_WAIT_L(0); PG8_BAR; PG8_MMA(0, 0, At, B0); PG8_MMA(0, 1, At, B1); PG8_BAR; PG8_SCHED;
            PG8_LDA(At, 0, 1); PG8_STAGE_B(PG8_SB(0, 0), b2); PG8_STAGE_B(PG8_SB(0, 1), b2 + hstepB); PG8_STAGE_A(PG8_SA(0, 0), a2, v2, 0);
            PG8_WAIT_V(8); PG8_WAIT_L(0); PG8_BAR; PG8_MMA(1, 0, At, B0); PG8_MMA(1, 1, At, B1); PG8_BAR; PG8_SCHED;
            PG8_LDB(B0, 1, 0); PG8_LDB(B1, 1, 1); PG8_SCHED; PG8_LDA(At, 1, 0); PG8_STAGE_A(PG8_SA(0, 1), a2, v2, 1);
            PG8_WAIT_V(8); PG8_WAIT_L(0); PG8_BAR; PG8_MMA(0, 0, At, B0); PG8_MMA(0, 1, At, B1); PG8_BAR; PG8_SCHED;
            PG8_LDA(At, 1, 1); PG8_STAGE_B(PG8_SB(1, 0), b3); PG8_STAGE_B(PG8_SB(1, 1), b3 + hstepB); PG8_STAGE_A(PG8_SA(1, 0), a3, v2, 0);
            PG8_WAIT_V(8); PG8_WAIT_L(0); PG8_BAR; PG8_MMA(1, 0, At, B0); PG8_MMA(1, 1, At, B1); PG8_BAR; PG8_SCHED;
        }
        if (wr == 0) PG8_BAR;
        if constexpr (F8) asm volatile("s_nop 15\n\ts_nop 7" : "+v"(acc[1][1][0][0]), "+v"(acc[1][1][0][1]), "+v"(acc[1][1][1][0]), "+v"(acc[1][1][1][1]), "+v"(acc[1][1][2][0]), "+v"(acc[1][1][2][1]), "+v"(acc[1][1][3][0]), "+v"(acc[1][1][3][1]) :: "memory");
        E(acc, cur, wr, wc, fr, fq, lds);
        if (S.edup_()) E(acc, cur, wr, wc, fr, fq, lds);
        if (!has_next) break;
#pragma unroll
        for (int a = 0; a < 2; ++a)
#pragma unroll
            for (int b = 0; b < 2; ++b)
#pragma unroll
                for (int m = 0; m < 4; ++m)
#pragma unroll
                    for (int n = 0; n < 2; ++n) acc[a][b][m][n] = (f32x4){0.f, 0.f, 0.f, 0.f};
        cur = nxt; cA = nA; cB = nB; ++ui;
        if constexpr (Sched::GATHER) {
#pragma unroll
        for (int h = 0; h < 2; ++h)
#pragma unroll
            for (int i = 0; i < 2; ++i) vAc[h][i] = vAn[h][i]; }
        if (wr == 1) PG8_BAR;
    }
    PG8_WAIT_V(0);
    PG8_BAR;
#undef PG8_SA
#undef PG8_SB
#undef PG8_STAGE_A
#undef PG8_STAGE_B
#undef PG8_LDA
#undef PG8_RD8
#undef PG8_LDB
#undef PG8_MMA
#undef PG8_WAIT_V
#undef PG8_WAIT_L
#undef PG8_SCHED
}

struct DenseRows {
    static constexpr bool GATHER = false, FP8 = false; static constexpr int SCALE_A = 0x7f7f7f7f, SCALE_B = 0x7f7f7f7f;
    int lda; int kdup = 1; int edup = 0;
    __device__ __forceinline__ int lda_() const { return lda; }
    __device__ __forceinline__ int kdup_() const { return kdup; }
    __device__ __forceinline__ int edup_() const { return edup; }
    __device__ __forceinline__ void rows(const Unit&, const int (&)[2], const int (&)[2], unsigned (&)[2][2]) const {}
};
struct PlainSched : DenseRows {
    const char* A; const char* B; char* C; int ldb, ldc, esz, nM, nN, G, c, bper; size_t bstride;
    __device__ __forceinline__ bool next(int i, Unit& u) const {
        int pm, pn; if (!static_map(i, G, c, nM, nN, pm, pn)) return false;
        u.pm = pm; u.pn = pn; u.A = A + (size_t)pm * BM * lda * 2; u.B = B + (size_t)pn * BM * ldb * 2 + (bper ? (size_t)(pm / bper) * bstride : 0);
        u.C = C + ((size_t)pm * BM * ldc + (size_t)pn * BM) * esz; u.row0 = pm * BM; u.aux = 0; return true;
    }
};
template <int WS, int AS> struct PlainSched8 : PlainSched {
    static constexpr bool FP8 = true; static constexpr int SCALE_A = AS * 0x01010101, SCALE_B = WS * 0x01010101;
    __device__ __forceinline__ bool next(int i, Unit& u) const {
        int pm, pn; if (!static_map(i, G, c, nM, nN, pm, pn)) return false;
        u.pm = pm; u.pn = pn; u.A = A + (size_t)pm * BM * lda; u.B = B + (size_t)pn * BM * ldb + (bper ? (size_t)(pm / bper) * bstride : 0);
        u.C = C + ((size_t)pm * BM * ldc + (size_t)pn * BM) * esz; u.row0 = pm * BM; u.aux = 0; return true;
    }
};
}
using pg8::Unit; using pg8::cvt_pk_bf16;

struct EpiRowScale {
    static constexpr bool PERM = true;
    const float* scale; int ldc; float mul = 1.f; bool f8out = false;
    __device__ __forceinline__ void operator()(f32x4 (&acc)[2][2][4][2], const Unit& u, int wr, int wc, int fr, int fq, LAS unsigned char*) const {
        asm volatile("" : "+v"(fr), "+v"(fq));
        const int r0 = wr * 64 + fr, c0 = wc * 32 + 8 * fq;
#pragma unroll
        for (int ai = 0; ai < 2; ++ai)
#pragma unroll
            for (int m = 0; m < 4; ++m) { const int r = r0 + ai * 128 + m * 16; const float s = (scale ? scale[u.row0 + r] : 1.f) * mul;
                bf16_t* rowp = (bf16_t*)u.C + (size_t)r * ldc + c0; unsigned char* rowp8 = (unsigned char*)u.C + (size_t)r * ldc + c0;
#pragma unroll
                for (int bj = 0; bj < 2; ++bj) { const f32x4 v0 = acc[ai][bj][m][0] * s, v1 = acc[ai][bj][m][1] * s;
                    if (f8out) { u32x2 w8; w8.x = pk_fp8x4(v0[0], v0[1], v0[2], v0[3]); w8.y = pk_fp8x4(v1[0], v1[1], v1[2], v1[3]); *(u32x2*)(rowp8 + bj * 128) = w8; }
                    else { u32x4 w; w.x = cvt_pk_bf16(v0[0], v0[1]); w.y = cvt_pk_bf16(v0[2], v0[3]); w.z = cvt_pk_bf16(v1[0], v1[1]); w.w = cvt_pk_bf16(v1[2], v1[3]);
                        *(u32x4*)(rowp + bj * 128) = w; } } }
    }
};
struct EpiResid {
    static constexpr bool PERM = true;
    const bf16_t* res; float* ssq; unsigned char* h8 = nullptr;
    __device__ __forceinline__ void operator()(f32x4 (&acc)[2][2][4][2], const Unit& u, int wr, int wc, int fr, int fq, LAS unsigned char* lds) const {
        asm volatile("" : "+v"(fr), "+v"(fq));
        const int r0 = wr * 64 + fr, c0 = wc * 32 + 8 * fq;
        LAS float* tab = (LAS float*)(lds + pg8::STAGE_BYTES);
        u32x4 rv[2][4][2];
#pragma unroll
        for (int ai = 0; ai < 2; ++ai)
#pragma unroll
            for (int m = 0; m < 4; ++m)
#pragma unroll
                for (int bj = 0; bj < 2; ++bj) rv[ai][m][bj] = *(const u32x4*)(res + (size_t)(u.row0 + r0 + ai * 128 + m * 16) * 1024 + u.pn * 256 + c0 + bj * 128);
#pragma unroll
        for (int ai = 0; ai < 2; ++ai)
#pragma unroll
            for (int m = 0; m < 4; ++m) { const int r = r0 + ai * 128 + m * 16; float q = 0.f;
                bf16_t* rowp = (bf16_t*)u.C + (size_t)r * 1024 + c0;
#pragma unroll
                for (int bj = 0; bj < 2; ++bj) { f32x4 v0 = acc[ai][bj][m][0], v1 = acc[ai][bj][m][1]; const u32x4 a = rv[ai][m][bj];
                    v0 += (f32x4){bflo(a.x), bfhi(a.x), bflo(a.y), bfhi(a.y)}; v1 += (f32x4){bflo(a.z), bfhi(a.z), bflo(a.w), bfhi(a.w)};
                    q += (v0[0] * v0[0] + v0[1] * v0[1]) + (v0[2] * v0[2] + v0[3] * v0[3]) + (v1[0] * v1[0] + v1[1] * v1[1]) + (v1[2] * v1[2] + v1[3] * v1[3]);
                    u32x4 w; w.x = cvt_pk_bf16(v0[0], v0[1]); w.y = cvt_pk_bf16(v0[2], v0[3]); w.z = cvt_pk_bf16(v1[0], v1[1]); w.w = cvt_pk_bf16(v1[2], v1[3]);
                    *(u32x4*)(rowp + bj * 128) = w;
                    if (h8) { u32x2 w8; w8.x = pk_fp8x4(v0[0], v0[1], v0[2], v0[3]); w8.y = pk_fp8x4(v1[0], v1[1], v1[2], v1[3]); *(u32x2*)(h8 + (size_t)(u.row0 + r) * 1024 + u.pn * 256 + c0 + bj * 128) = w8; } }
                q += __shfl_xor(q, 16); q += __shfl_xor(q, 32);
                if (fq == 0) tab[r * 4 + wc] = q; }
        asm volatile("s_waitcnt lgkmcnt(0)" ::: "memory"); __builtin_amdgcn_s_barrier(); asm volatile("" ::: "memory");
        { const int trow = (wr * 4 + wc) * 64 + fq * 16 + fr; if (trow < 256) { const f32x4 p = *(const LAS f32x4*)(tab + trow * 4); ssq[(size_t)(u.row0 + trow) * 4 + u.pn] = (p[0] + p[1]) + (p[2] + p[3]); } }
        asm volatile("s_waitcnt lgkmcnt(0)" ::: "memory"); __builtin_amdgcn_s_barrier(); asm volatile("" ::: "memory");
    }
};
struct EpiScoreF32 {
    static constexpr bool PERM = false;
    const float* ssq;
    __device__ __forceinline__ void operator()(f32x4 (&acc)[2][2][4][2], const Unit& u, int wr, int wc, int fr, int fq, LAS unsigned char*) const {
        asm volatile("" : "+v"(fr), "+v"(fq));
        const int r0 = wr * 64 + fr, c0 = wc * 32 + 4 * fq;
#pragma unroll
        for (int ai = 0; ai < 2; ++ai)
#pragma unroll
            for (int m = 0; m < 4; ++m) { const int r = r0 + ai * 128 + m * 16; const f32x4 p = *(const f32x4*)(ssq + (size_t)(u.row0 + r) * 4);
                const float s = rsqrtf(((p[0] + p[1]) + (p[2] + p[3])) * (1.f / 1024.f) + EPS);
                float* rowp = (float*)u.C + (size_t)r * 1024 + c0;
#pragma unroll
                for (int bj = 0; bj < 2; ++bj)
#pragma unroll
                    for (int n = 0; n < 2; ++n) *(f32x4*)(rowp + bj * 128 + n * 16) = acc[ai][bj][m][n] * s; }
    }
};
struct EpiSoftmax {
    static constexpr bool PERM = true;
    const float* ssq;
    __device__ __forceinline__ void operator()(f32x4 (&acc)[2][2][4][2], const Unit& u, int wr, int wc, int fr, int fq, LAS unsigned char* lds) const {
        LAS float* tabM = (LAS float*)(lds + pg8::STAGE_BYTES); LAS float* tabS = tabM + 1024;
        asm volatile("" : "+v"(fr), "+v"(fq));
        const int r0 = wr * 64 + fr, c0 = wc * 32 + 8 * fq;
        f32x4 pq[2][4];
#pragma unroll
        for (int ai = 0; ai < 2; ++ai)
#pragma unroll
            for (int m = 0; m < 4; ++m) pq[ai][m] = *(const f32x4*)(ssq + (size_t)(u.row0 + r0 + ai * 128 + m * 16) * 4);
#pragma unroll
        for (int ai = 0; ai < 2; ++ai)
#pragma unroll
            for (int m = 0; m < 4; ++m) { const int r = r0 + ai * 128 + m * 16; const f32x4 p = pq[ai][m];
                const float s = rsqrtf(((p[0] + p[1]) + (p[2] + p[3])) * (1.f / 1024.f) + EPS); float mx = -3.0e38f;
#pragma unroll
                for (int bj = 0; bj < 2; ++bj)
#pragma unroll
                    for (int n = 0; n < 2; ++n) { f32x4 v = acc[ai][bj][m][n] * s; acc[ai][bj][m][n] = v; mx = fmaxf(mx, fmaxf(fmaxf(v[0], v[1]), fmaxf(v[2], v[3]))); }
                mx = fmaxf(mx, __shfl_xor(mx, 16)); mx = fmaxf(mx, __shfl_xor(mx, 32));
                if (fq == 0) tabM[r * 4 + wc] = mx; }
        asm volatile("s_waitcnt lgkmcnt(0)" ::: "memory"); __builtin_amdgcn_s_barrier(); asm volatile("" ::: "memory");
#pragma unroll
        for (int ai = 0; ai < 2; ++ai)
#pragma unroll
            for (int m = 0; m < 4; ++m) { const int r = r0 + ai * 128 + m * 16; const f32x4 m4 = *(const LAS f32x4*)(tabM + r * 4);
                const float mx = fmaxf(fmaxf(m4[0], m4[1]), fmaxf(m4[2], m4[3])); float sum = 0.f;
#pragma unroll
                for (int bj = 0; bj < 2; ++bj)
#pragma unroll
                    for (int n = 0; n < 2; ++n) { f32x4 v = acc[ai][bj][m][n];
#pragma unroll
                        for (int j = 0; j < 4; ++j) { v[j] = __builtin_amdgcn_exp2f(v[j] - mx); sum += v[j]; }
                        acc[ai][bj][m][n] = v; }
                sum += __shfl_xor(sum, 16); sum += __shfl_xor(sum, 32);
                if (fq == 0) tabS[r * 4 + wc] = sum; }
        asm volatile("s_waitcnt lgkmcnt(0)" ::: "memory"); __builtin_amdgcn_s_barrier(); asm volatile("" ::: "memory");
#pragma unroll
        for (int ai = 0; ai < 2; ++ai)
#pragma unroll
            for (int m = 0; m < 4; ++m) { const int r = r0 + ai * 128 + m * 16; const f32x4 s4 = *(const LAS f32x4*)(tabS + r * 4);
                const float inv = (ATT_O_F8 ? 256.f : 1.f) / ((s4[0] + s4[1]) + (s4[2] + s4[3])); bf16_t* rowp = (bf16_t*)u.C + (size_t)r * 1024 + c0; unsigned char* rowp8 = (unsigned char*)u.C + (size_t)r * 1024 + c0;
#pragma unroll
                for (int bj = 0; bj < 2; ++bj) { const f32x4 v0 = acc[ai][bj][m][0] * inv, v1 = acc[ai][bj][m][1] * inv;
                    if (ATT_O_F8) { u32x2 w8; w8.x = pk_fp8x4(v0[0], v0[1], v0[2], v0[3]); w8.y = pk_fp8x4(v1[0], v1[1], v1[2], v1[3]); *(u32x2*)(rowp8 + bj * 128) = w8; }
                    else { u32x4 w; w.x = cvt_pk_bf16(v0[0], v0[1]); w.y = cvt_pk_bf16(v0[2], v0[3]); w.z = cvt_pk_bf16(v1[0], v1[1]); w.w = cvt_pk_bf16(v1[2], v1[3]);
                        *(u32x4*)(rowp + bj * 128) = w; } } }
    }
};
struct EpiSwiGLU {
    static constexpr bool PERM = true;
    const float* lrs;
    __device__ __forceinline__ void operator()(f32x4 (&acc)[2][2][4][2], const Unit& u, int wr, int wc, int fr, int fq, LAS unsigned char*) const {
        asm volatile("" : "+v"(fr), "+v"(fq));
        const int r0 = wr * 64 + fr, c0 = wc * 32 + 8 * fq;
        float rsv[2][4];
#pragma unroll
        for (int ai = 0; ai < 2; ++ai)
#pragma unroll
            for (int m = 0; m < 4; ++m) { const int r = r0 + ai * 128 + m * 16; rsv[ai][m] = r < u.row0 ? lrs[u.aux + r] : 0.f; }
#pragma unroll
        for (int ai = 0; ai < 2; ++ai)
#pragma unroll
            for (int m = 0; m < 4; ++m) { const int r = r0 + ai * 128 + m * 16; unsigned char* rowp = (unsigned char*)u.C + ((size_t)r * DEXP + c0) * (MOE_DN_F8 ? 1 : 2);
                const float rs = rsv[ai][m];
                const f32x4 g0 = acc[ai][0][m][0] * rs, g1 = acc[ai][0][m][1] * rs, u0 = acc[ai][1][m][0] * rs, u1 = acc[ai][1][m][1] * rs;
                f32x4 h0, h1;
#pragma unroll
                for (int j = 0; j < 4; ++j) { h0[j] = siluf(g0[j]) * u0[j]; h1[j] = siluf(g1[j]) * u1[j]; }
                if (MOE_DN_F8) { u32x2 w; w.x = pk_fp8x4(h0[0], h0[1], h0[2], h0[3]); w.y = pk_fp8x4(h1[0], h1[1], h1[2], h1[3]); *(u32x2*)rowp = w; }
                else { u32x4 w; w.x = cvt_pk_bf16(h0[0], h0[1]); w.y = cvt_pk_bf16(h0[2], h0[3]); w.z = cvt_pk_bf16(h1[0], h1[1]); w.w = cvt_pk_bf16(h1[2], h1[3]); *(u32x4*)rowp = w; } }
    }
};
struct MoeTab { const LAS int* t; __device__ __forceinline__ int ts(int e) const { return __builtin_amdgcn_readfirstlane(t[e]); } __device__ __forceinline__ int cnt(int e) const { return __builtin_amdgcn_readfirstlane(t[64 + e]); } };
__device__ __forceinline__ void moe_build_table(LAS unsigned char* lds, const unsigned* ctl, const int wv) {
    LAS int* t = (LAS int*)(lds + pg8::STAGE_BYTES + 4096);
    int tid_ = tid_from(wv); asm volatile("" : "+v"(tid_));
    if (tid_ < NEXP) t[64 + tid_] = (int)__hip_atomic_load(ctl + CW_CNT + tid_, __ATOMIC_RELAXED, __HIP_MEMORY_SCOPE_AGENT);
    __syncthreads();
    if (tid_ == 0) { int acc = 0; for (int e = 0; e < NEXP; ++e) { const int c = t[64 + e]; t[e] = acc; acc += (c + 255) >> 8; } t[NEXP] = acc; }
    __syncthreads();
}
__device__ __forceinline__ bool moe_map(const MoeTab& tb, int i, int G, int c, int& e, int& rt, int& pn, int& pmg) {
    const int nM = tb.ts(NEXP); int pm; if (!pg8::static_map(i, G, c, nM, 4, pm, pn)) return false;
    e = 0; for (int k = 1; k < NEXP; ++k) if (tb.ts(k) <= pm) e = k;
    rt = pm - tb.ts(e); pmg = pm; return true;
}
struct GateUpSched {
    static constexpr bool GATHER = true, FP8 = (MOE_GU_F8 != 0); static constexpr int SCALE_A = 0x7f7f7f7f, SCALE_B = 0x7a7a7a7a;
    static constexpr int ES = FP8 ? 1 : 2, HES = (MOE_DN_F8 != 0) ? 1 : 2;
    __device__ __forceinline__ int lda_() const { return 0; }
    __device__ __forceinline__ int kdup_() const { return 1; }
    __device__ __forceinline__ int edup_() const { return 0; }
    const char* hb; const char* wgu; char* hbuf; const int* lsrc; MoeTab tb; int ldb, G, c;
    __device__ __forceinline__ bool next(int i, Unit& u) const {
        int e, rt, pn, pmg; if (!moe_map(tb, i, G, c, e, rt, pn, pmg)) return false;
        u.pm = pmg; u.pn = pn; u.A = hb; u.B = wgu + ((size_t)e * 1024 + (size_t)pn * 256) * 1024 * ES; u.C = hbuf + ((size_t)pmg * 256 * DEXP + (size_t)pn * 128) * HES;
        u.aux = e * T + rt * 256; const int left = tb.cnt(e) - rt * 256; u.row0 = left < 256 ? left : 256; return true;
    }
    __device__ __forceinline__ void rows(const Unit& u, const int (&Rr)[2], const int (&Cc)[2], unsigned (&vA)[2][2]) const {
#pragma unroll
        for (int h = 0; h < 2; ++h)
#pragma unroll
            for (int i = 0; i < 2; ++i) { const int r = h * 128 + Rr[i]; const int tok = r < u.row0 ? lsrc[u.aux + r] : 0; vA[h][i] = (unsigned)(tok * 1024 * ES + Cc[i] * 2); }
    }
};
struct DownSched : pg8::DenseRows {
    static constexpr bool FP8 = (MOE_DN_F8 != 0); static constexpr int SCALE_A = 0x7f7f7f7f, SCALE_B = 0x7a7a7a7a; static constexpr int ES = FP8 ? 1 : 2;
    const char* hbuf; const char* wd; char* ysort; MoeTab tb; int ldb, G, c;
    __device__ __forceinline__ bool next(int i, Unit& u) const {
        int e, rt, pn, pmg; if (!moe_map(tb, i, G, c, e, rt, pn, pmg)) return false;
        u.pm = pmg; u.pn = pn; u.A = hbuf + (size_t)pmg * 256 * DEXP * ES; u.B = wd + ((size_t)e * 1024 + (size_t)pn * 256) * DEXP * ES; u.C = ysort + ((size_t)pmg * 256 * 1024 + (size_t)pn * 256);
        u.aux = e * T + rt * 256; const int left = tb.cnt(e) - rt * 256; u.row0 = left < 256 ? left : 256; return true;
    }
};
struct FoldSched : pg8::DenseRows {
    const char* kv; const char* wq; const char* wo; char* mt; char* nt; int ldb, G, c;
    __device__ __forceinline__ bool next(int i, Unit& u) const {
        const int L0 = i * G + c; if (L0 >= 256 || i > 0) return false;
        const int mode = L0 >> 7, L = L0 & 127, b = L >> 4, h = (L >> 2) & 3, q = L & 3;
        if (mode == 0) { u.A = kv + ((size_t)b * 256 * 2048 + h * 256) * 2; u.B = wq + ((size_t)q * 256 * 1024 + h * 256) * 2; u.C = mt + (((size_t)b * 1024 + h * 256) * 1024 + q * 256) * (ATT_S_F8 ? 1 : 2); }
        else { u.A = wo + ((size_t)q * 256 * 1024 + h * 256) * 2; u.B = kv + ((size_t)b * 256 * 2048 + 1024 + h * 256) * 2; u.C = nt + (((size_t)b * 1024 + q * 256) * 1024 + h * 256) * (ATT_O_F8 ? 1 : 2); }
        u.pm = 0; u.pn = 0; u.row0 = 0; u.aux = 0; return true;
    }
};

template <bool F8 = false> __device__ __forceinline__ void p0_tr64(const float* W, int ldw, void* WTv, int ldo, const float* gain, int glim, LAS float* scr, int k0, int lane, float scal = 1.f) {
    bf16_t* WT = (bf16_t*)WTv;
    f32x4 v[16]; const int kq = lane >> 4, n4 = (lane & 15) * 4;
#pragma unroll
    for (int i = 0; i < 16; ++i) v[i] = *(const f32x4*)(W + (size_t)(k0 + 4 * i + kq) * ldw + n4);
#pragma unroll
    for (int i = 0; i < 16; ++i) { const int k = 4 * i + kq; const float g = ((gain && (k0 + k) < glim) ? gain[k0 + k] : 1.f) * scal; LAS float* d = scr + k * 65 + n4;
        d[0] = v[i][0] * g; d[1] = v[i][1] * g; d[2] = v[i][2] * g; d[3] = v[i][3] * g; }
    asm volatile("s_waitcnt lgkmcnt(0)" ::: "memory");
    const int c = lane & 7;
#pragma unroll
    for (int j = 0; j < 8; ++j) { const int n = (lane >> 3) + 8 * j; const LAS float* s = scr + (8 * c) * 65 + n;
        if (F8) { u32x2 o; o.x = pk_fp8x4(s[0 * 65], s[1 * 65], s[2 * 65], s[3 * 65]); o.y = pk_fp8x4(s[4 * 65], s[5 * 65], s[6 * 65], s[7 * 65]); *(u32x2*)((unsigned char*)WTv + (size_t)n * ldo + k0 + 8 * c) = o; }
        else { u32x4 o; o.x = pk2(s[0 * 65], s[1 * 65]); o.y = pk2(s[2 * 65], s[3 * 65]); o.z = pk2(s[4 * 65], s[5 * 65]); o.w = pk2(s[6 * 65], s[7 * 65]);
            *(u32x4*)(WT + (size_t)n * ldo + k0 + 8 * c) = o; } }
    asm volatile("s_waitcnt lgkmcnt(0)" ::: "memory");
}

struct Params {
    const float* in[26]; float* out; unsigned char* ws;
};

__device__ __forceinline__ void p0_prologue(const Params& P, LAS unsigned char* lds, int vcu, int G, const int wv, const int parts = 3) {
    int tid_ = tid_from(wv); asm volatile("" : "+v"(tid_));
    const int tid = tid_, lane = tid & 63, wave = __builtin_amdgcn_readfirstlane(tid >> 6);
    const int gw = vcu * 8 + wave, NGW = G * 8;
    unsigned char* ws = P.ws;
    const float *w_in = P.in[4], *w_out = P.in[12], *w_q = P.in[14], *w_kv = P.in[15], *w_o = P.in[16], *w_gate = P.in[22], *w_up = P.in[23], *w_down = P.in[24];
    const float *norm_mem = P.in[2], *norm_mix = P.in[3], *norm_gate = P.in[10], *norm_xattn = P.in[13], *norm_moe = P.in[17];
    if (parts & 1) {
        LAS bf16_t* wtab = (LAS bf16_t*)lds;
#pragma unroll
        for (int it = 0; it < 32; ++it) { const int idx = tid + 512 * it, n = idx >> 10, k = idx & 1023; float v = 0.f;
            if (n < 8) v = w_in[(size_t)k * INCOLS + 1280 + n] * norm_mix[k];
            const unsigned hi = f2bf(v); const float rem = v - __builtin_bit_cast(float, hi << 16);
            wtab[idx] = (bf16_t)hi; wtab[16384 + idx] = (bf16_t)f2bf(rem); }
        __syncthreads();
        const float* x = P.in[0]; bf16_t* xb = (bf16_t*)(ws + WS_A); float* rstdx = (float*)(ws + WS_RSTDX); float* dtb = (float*)(ws + WS_DT); const float* dt_bias = P.in[7];
        const int fr = lane & 15, fq = lane >> 4;
        const int rpw = T / NGW, mbase = gw * rpw;
#pragma unroll 1
        for (int m0 = mbase; m0 < mbase + rpw; m0 += 16) {
            const float* xrow = x + (size_t)(m0 + fr) * D + 8 * fq; bf16_t* orow = xb + (size_t)(m0 + fr) * D + 8 * fq;
            int woff = fr * 1024 + 8 * fq; asm volatile("" : "+v"(woff));
            const LAS bf16_t* wl = wtab + woff;
            f32x4 acc = (f32x4){0.f, 0.f, 0.f, 0.f}; float ssq = 0.f;
            f32x4 xa[8][2], xbuf[8][2];
#define P0_LD(X, ks0) do { _Pragma("unroll") for (int _q = 0; _q < 8; ++_q) { X[_q][0] = *(const f32x4*)(xrow + 32 * ((ks0) + _q)); X[_q][1] = *(const f32x4*)(xrow + 32 * ((ks0) + _q) + 4); } } while (0)
#define P0_DO(X, ks0) do { _Pragma("unroll") for (int _q = 0; _q < 8; ++_q) { const f32x4 a = X[_q][0], b = X[_q][1]; \
                ssq += (a[0] * a[0] + a[1] * a[1]) + (a[2] * a[2] + a[3] * a[3]) + (b[0] * b[0] + b[1] * b[1]) + (b[2] * b[2] + b[3] * b[3]); \
                u32x4 h; h.x = pk2(a[0], a[1]); h.y = pk2(a[2], a[3]); h.z = pk2(b[0], b[1]); h.w = pk2(b[2], b[3]); \
                u32x4 l; l.x = pk2(a[0] - bflo(h.x), a[1] - bfhi(h.x)); l.y = pk2(a[2] - bflo(h.y), a[3] - bfhi(h.y)); l.z = pk2(b[0] - bflo(h.z), b[1] - bfhi(h.z)); l.w = pk2(b[2] - bflo(h.w), b[3] - bfhi(h.w)); \
                *(u32x4*)(orow + 32 * ((ks0) + _q)) = h; \
                const bf16x8 wh = *(const LAS bf16x8*)(wl + 32 * ((ks0) + _q)), wlo = *(const LAS bf16x8*)(wl + 16384 + 32 * ((ks0) + _q)); \
                const bf16x8 xh = __builtin_bit_cast(bf16x8, h), xl = __builtin_bit_cast(bf16x8, l); \
                acc = __builtin_amdgcn_mfma_f32_16x16x32_bf16(wh, xh, acc, 0, 0, 0); acc = __builtin_amdgcn_mfma_f32_16x16x32_bf16(wh, xl, acc, 0, 0, 0); acc = __builtin_amdgcn_mfma_f32_16x16x32_bf16(wlo, xh, acc, 0, 0, 0); \
                __builtin_amdgcn_sched_barrier(0); asm volatile("s_nop 15\n\ts_nop 15" : "+v"(acc)); __builtin_amdgcn_sched_barrier(0); } } while (0)
            P0_LD(xa, 0);
            P0_LD(xbuf, 8);  P0_DO(xa, 0);
            P0_LD(xa, 16);   P0_DO(xbuf, 8);
            P0_LD(xbuf, 24); P0_DO(xa, 16);
            P0_DO(xbuf, 24);
#undef P0_LD
#undef P0_DO
            ssq += __shfl_xor(ssq, 16); ssq += __shfl_xor(ssq, 32);
            const float rstd = rsqrtf(ssq * (1.f / D) + EPS);
            if (fq == 0) rstdx[m0 + fr] = rstd;
            if (fq < 2) { const f32x4 bb = *(const f32x4*)(dt_bias + 4 * fq); f32x4 o;
#pragma unroll
                for (int e = 0; e < 4; ++e) { const float raw = acc[e] * rstd + bb[e]; o[e] = raw > 20.f ? raw : log1pf(__expf(raw)); }
                *(f32x4*)(dtb + (size_t)(m0 + fr) * 8 + 4 * fq) = o; }
        }
        __syncthreads();
    }
    if (!(parts & 2)) return;
    LAS float* scr = (LAS float*)(lds + wave * 16640);
    constexpr int I_IN = 16 * 44, I_OUT = 16 * 16, I_KV = 16 * 32, I_O = 16 * 16, I_GU = 32 * 2 * 16 * 8, I_DN = 32 * 8 * 16;
    constexpr int NITEMS = I_IN + I_OUT + I_KV + I_O + I_GU + I_DN;
    for (int it = gw; it < NITEMS; it += NGW) {
        int r = it;
        if (r < I_IN) { const int kb = r / 44, nb = r % 44, n0 = nb * 64, sc = n0 < 1280 ? n0 : n0 + 8;
            p0_tr64(w_in + sc, INCOLS, (bf16_t*)(ws + WS_WIN) + (size_t)n0 * 1024, 1024, norm_mix, 1024, scr, kb * 64, lane); continue; } r -= I_IN;
        if (r < I_OUT) { const int kb = r / 16, nb = r % 16;
            p0_tr64(w_out + nb * 64, 1024, (bf16_t*)(ws + WS_WOUT) + (size_t)nb * 64 * 1024, 1024, norm_gate, 512, scr, kb * 64, lane); continue; } r -= I_OUT;
        if (r < I_KV) { const int kb = r / 32, nb = r % 32;
            p0_tr64(w_kv + nb * 64, 2048, (bf16_t*)(ws + WS_WKV) + (size_t)nb * 64 * 1024, 1024, norm_mem, 1024, scr, kb * 64, lane); continue; } r -= I_KV;
        if (r < I_O) { const int kb = r / 16, nb = r % 16;
            p0_tr64(w_o + nb * 64, 1024, (bf16_t*)(ws + WS_WO) + (size_t)nb * 64 * 1024, 1024, nullptr, 0, scr, kb * 64, lane); continue; } r -= I_O;
        if (r < I_GU) { const int e = r / 256, q = r % 256, up = q / 128, q2 = q % 128, kb = q2 / 8, nb = q2 % 8;
            const float* src = (up ? w_up : w_gate) + (size_t)e * 1024 * 512 + nb * 64; const int pn = nb / 2, j0 = (nb % 2) * 64 + up * 128;
            if (MOE_GU_F8) p0_tr64<true>(src, 512, (unsigned char*)(ws + WS_WGU) + ((size_t)e * 1024 + pn * 256 + j0) * 1024, 1024, norm_moe, 1024, scr, kb * 64, lane, 32.f);
            else p0_tr64<false>(src, 512, (bf16_t*)(ws + WS_WGU) + ((size_t)e * 1024 + pn * 256 + j0) * 1024, 1024, norm_moe, 1024, scr, kb * 64, lane); continue; } r -= I_GU;
        { const int e = r / 128, q = r % 128, kb = q / 16, nb = q % 16;
            if (MOE_DN_F8) p0_tr64<true>(w_down + (size_t)e * 512 * 1024 + nb * 64, 1024, (unsigned char*)(ws + WS_WD) + ((size_t)e * 1024 + nb * 64) * 512, 512, nullptr, 0, scr, kb * 64, lane, 32.f);
            else p0_tr64<false>(w_down + (size_t)e * 512 * 1024 + nb * 64, 1024, (bf16_t*)(ws + WS_WD) + ((size_t)e * 1024 + nb * 64) * 512, 512, nullptr, 0, scr, kb * 64, lane); }
    }
    { const int gt = vcu * 512 + tid, NT_ = G * 512; const float sc = LOG2E / 16.f;
        for (int i = gt; i < 1024 * 1024 / 4; i += NT_) { const f32x4 v = ((const f32x4*)w_q)[i]; const float g = norm_xattn[i >> 8] * sc;
            u32x2 o; o.x = pk2(v[0] * g, v[1] * g); o.y = pk2(v[2] * g, v[3] * g); ((u32x2*)(ws + WS_WQP))[i] = o; } }
    { const int gt = vcu * 512 + tid, NT_ = G * 512; const float* w_rg = P.in[18]; const float* w_re = P.in[20]; bf16_t* wr = (bf16_t*)(ws + WS_WR);
        for (int i = gt; i < 96 * 1024; i += NT_) { const int R = i >> 10, k = i & 1023, nt = R >> 4, j = 16 * (nt >> 1) + (R & 15); float v = 0.f;
            if (j < 36) v = (j < 4 ? w_rg[k * 4 + j] : w_re[k * 32 + j - 4]) * norm_moe[k];
            const unsigned hi = f2bf(v); const float rem = v - __builtin_bit_cast(float, hi << 16);
            wr[i] = (bf16_t)((nt & 1) ? f2bf(rem) : hi); } }
    { const float* mem = P.in[1]; bf16_t* mb = (bf16_t*)(ws + WS_MEMB); float* rstdm = (float*)(ws + WS_RSTDM);
        for (int m = gw; m < NMEM; m += NGW) {
            const f32x4* xr = (const f32x4*)(mem + (size_t)m * D) + lane; f32x4 v[4]; float s = 0.f;
#pragma unroll
            for (int j = 0; j < 4; ++j) { v[j] = xr[64 * j]; s += (v[j][0] * v[j][0] + v[j][1] * v[j][1]) + (v[j][2] * v[j][2] + v[j][3] * v[j][3]); }
            s = wave_sum(s);
            u32x2* o8 = (u32x2*)(mb + (size_t)m * D) + lane;
#pragma unroll
            for (int j = 0; j < 4; ++j) { u32x2 o; o.x = pk2(v[j][0], v[j][1]); o.y = pk2(v[j][2], v[j][3]); o8[64 * j] = o; }
            if (lane == 0) rstdm[m] = rsqrtf(s * (1.f / D) + EPS);
        } }
}

__device__ __forceinline__ void lds_barrier() { asm volatile("s_waitcnt lgkmcnt(0)" ::: "memory"); __builtin_amdgcn_s_barrier(); asm volatile("" ::: "memory"); }

typedef float f32x16 __attribute__((ext_vector_type(16)));
#define MFMA32(a, b, c) __builtin_amdgcn_mfma_f32_32x32x16_bf16((a), (b), (c), 0, 0, 0)
constexpr int SSD_XT = 0, SSD_BN = 66560, SSD_CN = SSD_BN + 16384, SSD_CS = SSD_CN + 16384, SSD_DT = SSD_CS + 4096, SSD_W = SSD_DT + 4096, SSD_PV = SSD_W + 4096;
static_assert(SSD_PV + 32768 <= 147456 - 16, "SSD LDS map");
constexpr int YL_STRIDE = 520;
__device__ __forceinline__ int fsw(int row) { return (row ^ (row >> 3)) & 15; }
__device__ __forceinline__ int crow(int reg, int hh) { return (reg & 3) + 8 * (reg >> 2) + 4 * hh; }
__device__ __forceinline__ bf16x8 pack8(float a0, float a1, float a2, float a3, float a4, float a5, float a6, float a7) {
    return __builtin_bit_cast(bf16x8, (u32x4){pk2(a0, a1), pk2(a2, a3), pk2(a4, a5), pk2(a6, a7)});
}
template <int MODE> __device__ __forceinline__ void ssd_tables(const Params& P, LAS unsigned char* lds, int ci, const int wv) {
    const int tid = tid_from(wv), lane = tid & 63, h = __builtin_amdgcn_readfirstlane(tid >> 6);
    const float* dtg = (const float*)(P.ws + WS_DT); const size_t t0 = (size_t)ci * 128;
    const float a2 = -__expf(P.in[8][h]) * LOG2E;
    const float d0 = dtg[(t0 + lane) * 8 + h], d1 = dtg[(t0 + 64 + lane) * 8 + h];
    float s0 = d0 * a2, s1 = d1 * a2;
#pragma unroll
    for (int o = 1; o < 64; o <<= 1) { const float u0 = __shfl_up(s0, o), u1 = __shfl_up(s1, o); if (lane >= o) { s0 += u0; s1 += u1; } }
    s1 += __shfl(s0, 63); const float last = __shfl(s1, 63);
    LAS float* cs = (LAS float*)(lds + SSD_CS) + h * 128; LAS float* dv = (LAS float*)(lds + SSD_DT) + h * 128; LAS float* wtab = (LAS float*)(lds + SSD_W) + h * 128;
    cs[lane] = s0; cs[lane + 64] = s1; dv[lane] = d0; dv[lane + 64] = d1;
    if (MODE == 1) { wtab[lane] = d0 * __builtin_amdgcn_exp2f(last - s0); wtab[lane + 64] = d1 * __builtin_amdgcn_exp2f(last - s1);
        if (lane == 0) ((float*)(P.ws + WS_CDEC))[ci * 8 + h] = __builtin_amdgcn_exp2f(last); }
    else { wtab[lane] = __builtin_amdgcn_exp2f(s0); wtab[lane + 64] = __builtin_amdgcn_exp2f(s1); }
}
template <bool TR> __device__ __forceinline__ void conv_task(const bf16_t* proj, size_t t0, int l0, int col, bool seq_start, const float* cw, const float* cb, int chw, const float (&sc)[8], u32x4 (&out)[8]) {
    u32x4 raw[11];
#pragma unroll
    for (int i = 0; i < 11; ++i) { const int row = l0 - 3 + i; if (seq_start && row < 0) raw[i] = (u32x4){0u, 0u, 0u, 0u}; else raw[i] = *(const u32x4*)(proj + (size_t)((long)t0 + row) * NPROJ + col); }
    f32x4 w[4][2];
#pragma unroll
    for (int k = 0; k < 4; ++k) { w[k][0] = *(const f32x4*)(cw + k * 768 + chw); w[k][1] = *(const f32x4*)(cw + k * 768 + chw + 4); }
    const f32x4 b0 = *(const f32x4*)(cb + chw), b1 = *(const f32x4*)(cb + chw + 4);
#pragma unroll
    for (int q = 0; q < 4; ++q) {
        float oa[8], ob[8];
        const float ba = (q < 2) ? b0[2 * (q & 1)] : b1[2 * (q & 1)], bb = (q < 2) ? b0[2 * (q & 1) + 1] : b1[2 * (q & 1) + 1];
#pragma unroll
        for (int i = 0; i < 8; ++i) { float a = ba, b = bb;
#pragma unroll
            for (int k = 0; k < 4; ++k) { const unsigned wd = raw[i + k][q]; a += w[k][q >> 1][2 * (q & 1)] * bflo(wd); b += w[k][q >> 1][2 * (q & 1) + 1] * bfhi(wd); }
            oa[i] = siluf(a); ob[i] = siluf(b); }
        if (TR) {
            out[2 * q] = (u32x4){pk2(oa[0] * sc[0], oa[1] * sc[1]), pk2(oa[2] * sc[2], oa[3] * sc[3]), pk2(oa[4] * sc[4], oa[5] * sc[5]), pk2(oa[6] * sc[6], oa[7] * sc[7])};
            out[2 * q + 1] = (u32x4){pk2(ob[0] * sc[0], ob[1] * sc[1]), pk2(ob[2] * sc[2], ob[3] * sc[3]), pk2(ob[4] * sc[4], ob[5] * sc[5]), pk2(ob[6] * sc[6], ob[7] * sc[7])};
        } else {
#pragma unroll
            for (int i = 0; i < 8; ++i) out[i][q] = pk2(oa[i], ob[i]);
        }
    }
}
__device__ __forceinline__ void s1_chunk(const Params& P, LAS unsigned char* lds, int ci, const int wv) {
    int tid_ = tid_from(wv); asm volatile("" : "+v"(tid_));
    const int tid = tid_, lane = tid & 63, wave = __builtin_amdgcn_readfirstlane(tid >> 6);
    const bf16_t* proj = (const bf16_t*)(P.ws + WS_PROJ); const size_t t0 = (size_t)ci * 128; const bool seq_start = (ci & 63) == 0;
    const float* cw = P.in[5]; const float* cb = P.in[6];
    ssd_tables<1>(P, lds, ci, wv);
    lds_barrier();
#pragma unroll 1
    for (int g = 0; g < 2; ++g) {
        { const int cg = tid & 31, run = tid >> 5, l0 = run * 8; u32x4 o[8];
            const LAS float* wvp = (const LAS float*)(lds + SSD_W) + (g * 4 + (cg >> 3)) * 128 + l0; const f32x4 w0 = *(const LAS f32x4*)wvp, w1 = *(const LAS f32x4*)(wvp + 4);
            const float sc[8] = {w0[0], w0[1], w0[2], w0[3], w1[0], w1[1], w1[2], w1[3]};
            conv_task<true>(proj, t0, l0, PC_XS + g * 256 + cg * 8, seq_start, cw, cb, g * 256 + cg * 8, sc, o);
#pragma unroll
            for (int j = 0; j < 8; ++j) { const int row = cg * 8 + j; *(LAS u32x4*)(lds + SSD_XT + row * 256 + ((run ^ fsw(row)) * 16)) = o[j]; } }
        asm volatile("" ::: "memory");
        if (tid < 128) { const int cg = tid & 7, run = tid >> 3, l0 = run * 8; u32x4 o[8]; const float sc[8] = {1.f, 1.f, 1.f, 1.f, 1.f, 1.f, 1.f, 1.f};
            conv_task<true>(proj, t0, l0, PC_B + g * 64 + cg * 8, seq_start, cw, cb, 512 + g * 64 + cg * 8, sc, o);
#pragma unroll
            for (int j = 0; j < 8; ++j) { const int row = cg * 8 + j; *(LAS u32x4*)(lds + SSD_BN + row * 256 + ((run ^ fsw(row)) * 16)) = o[j]; } }
        lds_barrier();
        { const int hl = wave >> 1, pt = wave & 1, r = lane & 31, hh = lane >> 5; f32x16 acc[2];
#pragma unroll
            for (int i = 0; i < 16; ++i) { acc[0][i] = 0.f; acc[1][i] = 0.f; }
            const int arow = hl * 64 + 32 * pt + r, fa = fsw(arow);
#pragma unroll
            for (int ks = 0; ks < 8; ++ks) { const int ch = 2 * ks + hh; const bf16x8 a = *(const LAS bf16x8*)(lds + SSD_XT + arow * 256 + ((ch ^ fa) * 16));
#pragma unroll
                for (int nt = 0; nt < 2; ++nt) { const int brow = 32 * nt + r; const bf16x8 b = *(const LAS bf16x8*)(lds + SSD_BN + brow * 256 + ((ch ^ fsw(brow)) * 16)); acc[nt] = MFMA32(a, b, acc[nt]); } }
            float* st = (float*)(P.ws + WS_STATES) + (((size_t)ci * 8 + g * 4 + hl) * 64 + 32 * pt) * 64;
#pragma unroll
            for (int nt = 0; nt < 2; ++nt)
#pragma unroll
                for (int reg = 0; reg < 16; ++reg) st[crow(reg, hh) * 64 + 32 * nt + r] = acc[nt][reg]; }
        lds_barrier();
    }
}
__device__ __forceinline__ void s2_scan(const Params& P, int blk, int nblk, const int wv) {
    int tid_ = tid_from(wv); asm volatile("" : "+v"(tid_));
    const float* states = (const float*)(P.ws + WS_STATES); bf16_t* prevb = (bf16_t*)(P.ws + WS_PREV); const float* cdec = (const float*)(P.ws + WS_CDEC);
    for (int idx = blk * 512 + tid_; idx < 65536; idx += nblk * 512) {
        const int b = idx >> 13, rem = idx & 8191, h = rem >> 10, e = (rem & 1023) * 4;
        f32x4 carry = (f32x4){0.f, 0.f, 0.f, 0.f};
#pragma unroll 8
        for (int c = 0; c < 64; ++c) { const int ci = b * 64 + c; const size_t off = ((size_t)ci * 8 + h) * 4096 + e;
            const f32x4 sv = *(const f32x4*)(states + off); u32x2 o; o.x = pk2(carry[0], carry[1]); o.y = pk2(carry[2], carry[3]); *(u32x2*)(prevb + off) = o;
            carry = carry * cdec[ci * 8 + h] + sv; }
    }
}
__device__ __forceinline__ void s3_chunk(const Params& P, LAS unsigned char* lds, int ci, const int wv) {
    int tid_ = tid_from(wv); asm volatile("" : "+v"(tid_));
    int tid = tid_, lane = tid & 63; const int wave = __builtin_amdgcn_readfirstlane(tid >> 6);
    const bf16_t* proj = (const bf16_t*)(P.ws + WS_PROJ); bf16_t* ycat = (bf16_t*)(P.ws + WS_YCAT); const size_t t0 = (size_t)ci * 128; const bool seq_start = (ci & 63) == 0;
    const float* cw = P.in[5]; const float* cb = P.in[6];
    ssd_tables<3>(P, lds, ci, wv);
    u32x4 sra[6], srb[6], sgb[4];
#define SC_LOAD(qb) do { const int _cg = tid & 63, _l0 = (tid >> 6) * 16 + (qb) * 4; \
        _Pragma("unroll") for (int _i = 0; _i < 6; ++_i) { const int _row = _l0 - 2 + _i; \
            if (seq_start && _row < 0) { sra[_i] = (u32x4){0u, 0u, 0u, 0u}; srb[_i] = sra[_i]; } \
            else { const size_t _ro = (size_t)((long)t0 + _row) * NPROJ + _cg * 8; sra[_i] = *(const u32x4*)(proj + _ro + PC_GC); srb[_i] = *(const u32x4*)(proj + _ro + PC_V); } } \
        _Pragma("unroll") for (int _i = 0; _i < 4; ++_i) sgb[_i] = *(const u32x4*)(proj + (t0 + _l0 + _i) * NPROJ + PC_GB + _cg * 8); } while (0)
#define SC_COMPUTE(qb) do { const int _cg = tid & 63, _l0 = (tid >> 6) * 16 + (qb) * 4; const float* _sw = P.in[11]; f32x4 _w[3][2]; \
        _Pragma("unroll") for (int _k = 0; _k < 3; ++_k) { _w[_k][0] = *(const f32x4*)(_sw + _k * 512 + _cg * 8); _w[_k][1] = *(const f32x4*)(_sw + _k * 512 + _cg * 8 + 4); } \
        _Pragma("unroll") for (int _i = 0; _i < 4; ++_i) { u32x4 _o; \
            _Pragma("unroll") for (int _q = 0; _q < 4; ++_q) { float _a = 0.f, _b = 0.f; \
                _Pragma("unroll") for (int _k = 0; _k < 3; ++_k) { _a += _w[_k][_q >> 1][2 * (_q & 1)] * (bflo(sra[_i + _k][_q]) * bflo(srb[_i + _k][_q])); _b += _w[_k][_q >> 1][2 * (_q & 1) + 1] * (bfhi(sra[_i + _k][_q]) * bfhi(srb[_i + _k][_q])); } \
                _o[_q] = pk2(_a * bflo(sgb[_i][_q]), _b * bfhi(sgb[_i][_q])); } \
            *(u32x4*)(ycat + (t0 + _l0 + _i) * 1024 + 512 + _cg * 8) = _o; } } while (0)
    lds_barrier();
#pragma unroll 1
    for (int g = 0; g < 2; ++g) {
        asm volatile("" : "+v"(tid)); lane = tid & 63;
        SC_LOAD(2 * g);
        for (int rep_ = 0; rep_ < (PROBE_DUP == 31 ? 2 : 1); ++rep_) {
        { const int cg = tid & 31, run = tid >> 5, l0 = run * 8; u32x4 o[8]; const float sc[8] = {1.f, 1.f, 1.f, 1.f, 1.f, 1.f, 1.f, 1.f};
            conv_task<true>(proj, t0, l0, PC_XS + g * 256 + cg * 8, seq_start, cw, cb, g * 256 + cg * 8, sc, o);
            const bool sw4 = (cg >> 1) & 1;
#pragma unroll
            for (int j = 0; j < 8; ++j) { const int row = cg * 8 + j; u32x4 v; v.x = sw4 ? o[j].z : o[j].x; v.y = sw4 ? o[j].w : o[j].y; v.z = sw4 ? o[j].x : o[j].z; v.w = sw4 ? o[j].y : o[j].w;
                *(LAS u32x4*)(lds + SSD_XT + row * 256 + ((run ^ fsw(row)) * 16)) = v; } }
        asm volatile("" ::: "memory");
        if (tid < 256) { const int which = tid >> 7, cg = tid & 7, run = (tid >> 3) & 15, l0 = run * 8; u32x4 o[8]; const float sc[8] = {1.f, 1.f, 1.f, 1.f, 1.f, 1.f, 1.f, 1.f};
            conv_task<false>(proj, t0, l0, (which ? PC_C : PC_B) + g * 64 + cg * 8, seq_start, cw, cb, (which ? 640 : 512) + g * 64 + cg * 8, sc, o);
            LAS unsigned char* img = lds + (which ? SSD_CN : SSD_BN);
#pragma unroll
            for (int i = 0; i < 8; ++i) { const int row = l0 + i; *(LAS u32x4*)(img + row * 128 + ((cg ^ ((row >> 1) & 7)) * 16)) = o[i]; } }
        { const u32x4* pg = (const u32x4*)((const bf16_t*)(P.ws + WS_PREV) + ((size_t)ci * 8 + g * 4) * 4096);
#pragma unroll
            for (int i = 0; i < 4; ++i) { const int q = tid + 512 * i, row = q >> 3, chv = q & 7; *(LAS u32x4*)(lds + SSD_PV + row * 128 + ((chv ^ ((row >> 1) & 7)) * 16)) = pg[q]; } }
        if (rep_ == 0) { SC_COMPUTE(2 * g); SC_LOAD(2 * g + 1); }
        lds_barrier(); }
        const int hl = wave >> 1, half = wave & 1, hh = lane >> 5, h = g * 4 + hl; int r = lane & 31;
        f32x16 accs[2][2];
        for (int rep_ = 0; rep_ < (PROBE_DUP == 32 ? 2 : 1); ++rep_)
        {
            const float dsk = P.in[9][h];
            const LAS float* csT = (const LAS float*)(lds + SSD_CS) + h * 128; const LAS float* dtT = (const LAS float*)(lds + SSD_DT) + h * 128; const LAS float* exT = (const LAS float*)(lds + SSD_W) + h * 128;
            const int b4 = (r >> 4) & 1;
#pragma unroll
            for (int li = 0; li < 2; ++li) {
                if (li == 1) asm volatile("" : "+v"(r) : "v"(accs[0][0][0]), "v"(accs[0][1][0]));
                const int lt = half ? (li ? 2 : 1) : (li ? 3 : 0); const int l = 32 * lt + r;
                f32x16 a0, a1;
#pragma unroll
                for (int i = 0; i < 16; ++i) { a0[i] = 0.f; a1[i] = 0.f; }
                bf16x8 cf[4];
#pragma unroll
                for (int ks = 0; ks < 4; ++ks) cf[ks] = *(const LAS bf16x8*)(lds + SSD_CN + l * 128 + (((2 * ks + hh) ^ ((l >> 1) & 7)) * 16));
                const float csl = csT[l];
                for (int st = 0; st <= lt; ++st) {
                    f32x16 X;
#pragma unroll
                    for (int i = 0; i < 16; ++i) X[i] = 0.f;
                    const int srow = 32 * st + r;
#pragma unroll
                    for (int ks = 0; ks < 4; ++ks) { const bf16x8 bfr = *(const LAS bf16x8*)(lds + SSD_BN + srow * 128 + (((2 * ks + hh) ^ ((srow >> 1) & 7)) * 16)); X = MFMA32(bfr, cf[ks], X); }
                    const bool diag = (st == lt);
#pragma unroll
                    for (int q = 0; q < 4; ++q) { const int sb = 32 * st + 8 * q + 4 * hh; const f32x4 c4 = *(const LAS f32x4*)(csT + sb), d4 = *(const LAS f32x4*)(dtT + sb);
#pragma unroll
                        for (int i = 0; i < 4; ++i) { const int s = sb + i; float f = __builtin_amdgcn_exp2f(csl - c4[i]) * d4[i];
                            if (diag) f = (s <= l) ? f : 0.f;
                            float v = X[4 * q + i] * f; if (diag) v = (s == l) ? v + dsk : v; X[4 * q + i] = v; } }
                    const bf16x8 xb0 = pack8(X[0], X[1], X[2], X[3], X[4], X[5], X[6], X[7]), xb1 = pack8(X[8], X[9], X[10], X[11], X[12], X[13], X[14], X[15]);
#pragma unroll
                    for (int sp = 0; sp < 2; ++sp)
#pragma unroll
                        for (int pt = 0; pt < 2; ++pt) { const int row = hl * 64 + 32 * pt + r, ch = 4 * st + 2 * sp, fr_ = fsw(row);
                            const u32x2 p1 = *(const LAS u32x2*)(lds + SSD_XT + row * 256 + (((ch ^ fr_) * 2 + (hh ^ b4)) * 8)), p2 = *(const LAS u32x2*)(lds + SSD_XT + row * 256 + ((((ch + 1) ^ fr_) * 2 + (hh ^ b4)) * 8));
                            const bf16x8 af = __builtin_bit_cast(bf16x8, (u32x4){p1.x, p1.y, p2.x, p2.y});
                            if (pt == 0) a0 = MFMA32(af, sp ? xb1 : xb0, a0); else a1 = MFMA32(af, sp ? xb1 : xb0, a1); }
                }
                const float el = exT[l];
                bf16x8 pf[2][4];
#pragma unroll
                for (int pt = 0; pt < 2; ++pt)
#pragma unroll
                    for (int ks = 0; ks < 4; ++ks) { const int prow = hl * 64 + 32 * pt + r; pf[pt][ks] = *(const LAS bf16x8*)(lds + SSD_PV + prow * 128 + (((2 * ks + hh) ^ ((prow >> 1) & 7)) * 16)); }
#pragma unroll
                for (int ks = 0; ks < 4; ++ks) { const u32x4 cw4 = __builtin_bit_cast(u32x4, cf[ks]);
                    const bf16x8 cs_ = pack8(bflo(cw4.x) * el, bfhi(cw4.x) * el, bflo(cw4.y) * el, bfhi(cw4.y) * el, bflo(cw4.z) * el, bfhi(cw4.z) * el, bflo(cw4.w) * el, bfhi(cw4.w) * el);
                    a0 = MFMA32(pf[0][ks], cs_, a0); a1 = MFMA32(pf[1][ks], cs_, a1); }
                accs[li][0] = a0; accs[li][1] = a1;
            }
        }
        SC_COMPUTE(2 * g + 1);
        u32x4 zpre[8];
#pragma unroll
        for (int i = 0; i < 8; ++i) zpre[i] = *(const u32x4*)(proj + (t0 + (tid >> 5) + 16 * i) * NPROJ + PC_Z + g * 256 + (tid & 31) * 8);
        lds_barrier();
        for (int rep_ = 0; rep_ < (PROBE_DUP == 33 ? 2 : 1); ++rep_) {
#pragma unroll
        for (int li = 0; li < 2; ++li) { const int lt = half ? (li ? 2 : 1) : (li ? 3 : 0); const int l = 32 * lt + r;
#pragma unroll
            for (int pt = 0; pt < 2; ++pt)
#pragma unroll
                for (int q = 0; q < 4; ++q) { u32x2 o; o.x = cvt_pk_bf16(accs[li][pt][4 * q], accs[li][pt][4 * q + 1]); o.y = cvt_pk_bf16(accs[li][pt][4 * q + 2], accs[li][pt][4 * q + 3]);
                    *(LAS u32x2*)(lds + SSD_XT + l * YL_STRIDE + (hl * 64 + 32 * pt + 8 * q + 4 * hh) * 2) = o; } }
        lds_barrier();
        { const int cg = tid & 31;
#pragma unroll
            for (int i = 0; i < 8; ++i) { const int l = (tid >> 5) + 16 * i;
                const u32x2 y0 = *(const LAS u32x2*)(lds + SSD_XT + l * YL_STRIDE + cg * 16), y1 = *(const LAS u32x2*)(lds + SSD_XT + l * YL_STRIDE + cg * 16 + 8);
                const u32x4 z = zpre[i];
                const unsigned yw[4] = {y0.x, y0.y, y1.x, y1.y}; float v[8]; float q = 0.f;
#pragma unroll
                for (int k = 0; k < 4; ++k) { v[2 * k] = bflo(yw[k]) * siluf(bflo(z[k])); v[2 * k + 1] = bfhi(yw[k]) * siluf(bfhi(z[k])); q += v[2 * k] * v[2 * k] + v[2 * k + 1] * v[2 * k + 1]; }
                q = row16_sum(q); q += __shfl_xor(q, 16);
                const float rs = rsqrtf(q * (1.f / 256.f) + EPS);
                u32x4 o; o.x = pk2(v[0] * rs, v[1] * rs); o.y = pk2(v[2] * rs, v[3] * rs); o.z = pk2(v[4] * rs, v[5] * rs); o.w = pk2(v[6] * rs, v[7] * rs);
                *(u32x4*)(ycat + (t0 + l) * 1024 + g * 256 + cg * 8) = o; } }
        lds_barrier(); }
    }
}
#undef SC_LOAD
#undef SC_COMPUTE

#define XB_TMO      128
#define XB_XCNT(j)  (256  + 64 * (j))
#define XB_XSUB(j)  (1280 + 64 * (j))
#define XB_XGEN(j)  (2304 + 64 * (j))
#define XB_TOP      3328
#define XB_TOPGEN   3392
#define XCD_BAR_WORDS 3456
#define XB_SPIN_CAP (1u << 18)

__device__ __forceinline__ unsigned xb_ld(unsigned* p)              { return __hip_atomic_load(p, __ATOMIC_RELAXED, __HIP_MEMORY_SCOPE_AGENT); }
__device__ __forceinline__ unsigned xb_add(unsigned* p, unsigned v) { return __hip_atomic_fetch_add(p, v, __ATOMIC_RELAXED, __HIP_MEMORY_SCOPE_AGENT); }
__device__ __forceinline__ unsigned xb_xcc_id() { return (unsigned)__builtin_amdgcn_s_getreg((3 << 11) | 20) & 0xFu; }
#define XB_SPIN(cond, bar) do { unsigned _sp = 0; while (cond) { __builtin_amdgcn_s_sleep(1); \
    if ((++_sp & 255u) == 0u) { if (xb_ld(&(bar)[XB_TMO])) break; if (_sp > XB_SPIN_CAP) { atomicAdd(&(bar)[XB_TMO], 1u); break; } } } } while (0)

struct XcdBarrier {
    unsigned* bar; unsigned x;
    volatile LAS unsigned* st;
};

__device__ __forceinline__ XcdBarrier xcd_barrier_post(unsigned* bar, volatile LAS unsigned* st, const bool t0) {
    XcdBarrier b; b.bar = bar; b.x = xb_xcc_id(); b.st = st;
    if (t0) (void)xb_add(&bar[XB_XCNT(b.x)], 1u);
    return b;
}
__device__ __forceinline__ void xcd_barrier_complete(unsigned* bar, unsigned x, unsigned& nloc, unsigned& nx) {
    const unsigned G = gridDim.x * gridDim.y * gridDim.z;
    unsigned sum, cnt, mine, sp = 0u;
    for (;;) {
        sum = 0u; cnt = 0u; mine = 0u;
#pragma unroll
        for (unsigned j = 0; j < 16; ++j) { const unsigned c = xb_ld(&bar[XB_XCNT(j)]); sum += c; cnt += (c > 0u) ? 1u : 0u; mine = (j == x) ? c : mine; }
        if (sum == G) break;
        __builtin_amdgcn_s_sleep(1);
        if ((++sp & 255u) == 0u) { if (xb_ld(&bar[XB_TMO])) break; if (sp > XB_SPIN_CAP) { atomicAdd(&bar[XB_TMO], 1u); break; } }
    }
    nloc = mine > 0u ? mine : 1u; nx = cnt > 0u ? cnt : 1u;
}

__device__ __forceinline__ void xcd_barrier(const XcdBarrier& b, const bool t0) {
    asm volatile("s_waitcnt vmcnt(0)" ::: "memory");
    __syncthreads();
    if (t0) {
        unsigned* bar = b.bar;
        __builtin_amdgcn_s_waitcnt(0);
        unsigned nloc = b.st[0], nx = b.st[1];
        if (nloc == 0u) { xcd_barrier_complete(bar, b.x, nloc, nx); b.st[0] = nloc; b.st[1] = nx; }
        const unsigned old = xb_add(&bar[XB_XSUB(b.x)], 1u);
        const unsigned gen = old / nloc;
        if (old + 1u == (gen + 1u) * nloc) {
            __builtin_amdgcn_fence(__ATOMIC_RELEASE, "agent");
            asm volatile("s_waitcnt vmcnt(0)" ::: "memory");
            const unsigned og = xb_add(&bar[XB_TOP], 1u);
            const unsigned tg = og / nx;
            if (og + 1u == (tg + 1u) * nx) xb_add(&bar[XB_TOPGEN], 1u);
            else XB_SPIN(xb_ld(&bar[XB_TOPGEN]) == tg, bar);
            __builtin_amdgcn_fence(__ATOMIC_ACQUIRE, "agent");
            xb_add(&bar[XB_XGEN(b.x)], 1u);
            asm volatile("s_waitcnt vmcnt(0)" ::: "memory");
        } else {
            XB_SPIN(xb_ld(&bar[XB_XGEN(b.x)]) == gen, bar);
            __builtin_amdgcn_fence(__ATOMIC_ACQUIRE, "agent");
            asm volatile("s_waitcnt vmcnt(0)" ::: "memory");
        }
    }
    __syncthreads();
}


constexpr int RT_W = 0, RT_LOG = 0, RT_CNT = 98304, RT_BASE = RT_CNT + 1024;
__device__ __forceinline__ void m1_router(const Params& P, LAS unsigned char* lds, int blk, int nblk, const int wv, const XcdBarrier& bar) {
    int tid_ = tid_from(wv); asm volatile("" : "+v"(tid_));
    const int tid = tid_, lane = tid & 63, wave = __builtin_amdgcn_readfirstlane(tid >> 6), fr = lane & 15, fq = lane >> 4;
    unsigned char* ws = P.ws; const bf16_t* h2 = (const bf16_t*)(ws + WS_H2); const bf16_t* wr = (const bf16_t*)(ws + WS_WR);
    const float* ssq2 = (const float*)(ws + WS_SSQ2); unsigned* gcnt = (unsigned*)(ws + WS_CTL) + CW_CNT;
    int* lsrc = (int*)(ws + WS_LSRC); float* lrs = (float*)(ws + WS_LRS); int* tslot = (int*)(ws + WS_TSLOT); float* tcomb = (float*)(ws + WS_TSLOT + MiB);
    const float* b_rg = P.in[19]; const float* b_re = P.in[21];
    LAS int* lcnt = (LAS int*)(lds + RT_CNT); LAS int* lbase = (LAS int*)(lds + RT_BASE);
    { const int tile = blk;
        const int tb = tile * 256 + wave * 32;
        f32x4 acc[2][6];
#pragma unroll
        for (int a = 0; a < 2; ++a)
#pragma unroll
            for (int b = 0; b < 6; ++b) acc[a][b] = (f32x4){0.f, 0.f, 0.f, 0.f};
        bf16x8 ha[4][2], hb[4][2];
        const bf16_t* hrow = h2 + (size_t)(tb + fr) * 1024 + 8 * fq;
#define RT_LOADH(F, ks0) do { const bf16_t* _h = hrow + 32 * (ks0); _Pragma("unroll") for (int _q = 0; _q < 4; ++_q) _Pragma("unroll") for (int _m = 0; _m < 2; ++_m) F[_q][_m] = *(const bf16x8*)(_h + (size_t)_m * 16 * 1024 + 32 * _q); } while (0)
#define RT_MMAH(F, kl0) do { const LAS unsigned char* _w = lds + RT_W + fr * 1024; const int _c0 = 4 * (kl0) + fq; _Pragma("unroll") for (int _q = 0; _q < 4; ++_q) { bf16x8 wf[6]; \
            _Pragma("unroll") for (int _n = 0; _n < 6; ++_n) wf[_n] = *(const LAS bf16x8*)(_w + _n * 16384 + (((_c0 + 4 * _q) ^ fr) * 16)); \
            _Pragma("unroll") for (int _m = 0; _m < 2; ++_m) _Pragma("unroll") for (int _n = 0; _n < 6; ++_n) acc[_m][_n] = __builtin_amdgcn_mfma_f32_16x16x32_bf16(wf[_n], F[_q][_m], acc[_m][_n], 0, 0, 0); } } while (0)
#define RT_COPYW(half) do { __syncthreads();   \
            const u32x4* src = (const u32x4*)wr; \
            _Pragma("unroll") for (int i = 0; i < 12; ++i) { const int q = tid + 512 * i, row = q >> 6, ch = q & 63; *(LAS u32x4*)(lds + RT_W + row * 1024 + ((ch ^ (row & 15)) * 16)) = src[row * 128 + (half) * 64 + ch]; } \
            __syncthreads(); } while (0)
        RT_LOADH(ha, 0);
#pragma unroll 1
        for (int half = 0; half < 2; ++half) {
            RT_COPYW(half);
#pragma unroll 1
            for (int g = 0; g < 2; ++g) { const int ks = half * 16 + g * 8;
                RT_LOADH(hb, ks + 4); RT_MMAH(ha, g * 8);
                if (ks + 8 < 32) RT_LOADH(ha, ks + 8);
                RT_MMAH(hb, g * 8 + 4); } }
#undef RT_COPYW
#undef RT_LOADH
#undef RT_MMAH
        __syncthreads();
        LAS float* lt = (LAS float*)(lds + RT_LOG) + wave * 32 * 48;
#pragma unroll
        for (int mt = 0; mt < 2; ++mt)
#pragma unroll
            for (int gp = 0; gp < 3; ++gp) *(LAS f32x4*)(lt + (16 * mt + fr) * 48 + 16 * gp + 4 * fq) = acc[mt][2 * gp] + acc[mt][2 * gp + 1];
        __syncthreads();
        int e1 = 0, e2 = 0, r1 = 0, r2 = 0; float c1 = 0.f, c2 = 0.f, rstd_t = 0.f; const int t = tb + lane;
        if (lane < 32) {
            const f32x4 p = *(const f32x4*)(ssq2 + (size_t)t * 4); const float rstd = rsqrtf(((p[0] + p[1]) + (p[2] + p[3])) * (1.f / 1024.f) + EPS);
            rstd_t = rstd;
            const LAS float* row = lt + lane * 48; const f32x4 g4 = *(const LAS f32x4*)row;
            float gl[4]; int gi = 0;
#pragma unroll
            for (int j = 0; j < 4; ++j) gl[j] = g4[j] * rstd + b_rg[j];
#pragma unroll
            for (int j = 1; j < 4; ++j) if (gl[j] > gl[gi]) gi = j;
            float gs = 0.f;
#pragma unroll
            for (int j = 0; j < 4; ++j) gs += __expf(gl[j] - gl[gi]);
            const float gw = 1.f / gs;
            const f32x4 ea = *(const LAS f32x4*)(row + 4 + gi * 8), eb = *(const LAS f32x4*)(row + 8 + gi * 8);
            const f32x4 ba = *(const f32x4*)(b_re + gi * 8), bb = *(const f32x4*)(b_re + gi * 8 + 4);
            float el[8];
#pragma unroll
            for (int j = 0; j < 4; ++j) { el[j] = ea[j] * rstd + ba[j]; el[4 + j] = eb[j] * rstd + bb[j]; }
            int i1 = 0;
#pragma unroll
            for (int j = 1; j < 8; ++j) if (el[j] > el[i1]) i1 = j;
            int i2 = (i1 == 0) ? 1 : 0;
#pragma unroll
            for (int j = 0; j < 8; ++j) if (j != i1 && el[j] > el[i2]) i2 = j;
            float v1 = el[0], v2 = el[0];
#pragma unroll
            for (int j = 1; j < 8; ++j) { v1 = (i1 == j) ? el[j] : v1; v2 = (i2 == j) ? el[j] : v2; }
            const float w1 = 1.f / (1.f + __expf(v2 - v1));
            c1 = gw * w1; c2 = gw * (1.f - w1); e1 = gi * 8 + i1; e2 = gi * 8 + i2;
        }
        const bool act = lane < 32;
#pragma unroll 1
        for (int e = 0; e < NEXP; ++e) { const unsigned long long m1 = __ballot(act && e1 == e), m2 = __ballot(act && e2 == e); const unsigned long long below = (1ull << lane) - 1ull;
            if (act && e1 == e) r1 = __popcll(m1 & below);
            if (act && e2 == e) r2 = __popcll(m2 & below);
            if (lane == 0) lcnt[wave * 32 + e] = __popcll(m1) | (__popcll(m2) << 16); }
        __syncthreads();
        unsigned* gtc = (unsigned*)(ws + WS_CTL) + CW_TCNT;
        if (tid < 32) { int run = 0;
#pragma unroll
            for (int w = 0; w < 8; ++w) { const int v = lcnt[w * 32 + tid]; lbase[64 + w * 32 + tid] = run; run += (v & 0xffff) + (v >> 16); }
            __hip_atomic_store(gtc + tile * 32 + tid, (unsigned)run, __ATOMIC_RELAXED, __HIP_MEMORY_SCOPE_AGENT); atomicAdd(gcnt + tid, (unsigned)run); }
        xcd_barrier(bar, tid == 0);
        { const int e = tid & 31, part = tid >> 5; int s_ = 0;
            unsigned pv[16];
#pragma unroll
            for (int j = 0; j < 16; ++j) { const int t2 = part + 16 * j; pv[j] = t2 < tile ? __hip_atomic_load(gtc + t2 * 32 + e, __ATOMIC_RELAXED, __HIP_MEMORY_SCOPE_AGENT) : 0u; }
#pragma unroll
            for (int j = 0; j < 16; ++j) s_ += (int)pv[j];
            lbase[320 + part * 32 + e] = s_; }
        __syncthreads();
        if (tid < 32) { int s_ = 0;
#pragma unroll
            for (int q = 0; q < 16; ++q) s_ += lbase[320 + q * 32 + tid];
            lbase[tid] = s_; }
        __syncthreads();
        if (act) { const int q1 = lbase[e1] + lbase[64 + wave * 32 + e1] + r1, q2 = lbase[e2] + lbase[64 + wave * 32 + e2] + (lcnt[wave * 32 + e2] & 0xffff) + r2;
            const size_t p1 = (size_t)e1 * T + q1, p2 = (size_t)e2 * T + q2;
            lsrc[p1] = t; lrs[p1] = rstd_t; lsrc[p2] = t; lrs[p2] = rstd_t;
            *(int2*)(tslot + 2 * (size_t)t) = make_int2((e1 << 16) | q1, (e2 << 16) | q2); *(float2*)(tcomb + 2 * (size_t)t) = make_float2(c1, c2); }
    }
}
__device__ __forceinline__ void m5_final(const Params& P, LAS unsigned char* lds, int vcu, int ngw, const int wv) {
    moe_build_table(lds, (const unsigned*)(P.ws + WS_CTL), wv);
    const LAS int* tst = (const LAS int*)(lds + pg8::STAGE_BYTES + 4096);
    int tid_ = tid_from(wv); asm volatile("" : "+v"(tid_));
    const int lane = tid_ & 63, gw = vcu * 8 + (tid_ >> 6); const bf16_t* h2 = (const bf16_t*)(P.ws + WS_H2); const unsigned char* Y = (const unsigned char*)(P.ws + WS_Y); const float* g = P.in[25]; float* out = P.out;
    const int* tslot = (const int*)(P.ws + WS_TSLOT); const float* tcomb = (const float*)(P.ws + WS_TSLOT + MiB);
    f32x4 gg[4];
#pragma unroll
    for (int j = 0; j < 4; ++j) gg[j] = *(const f32x4*)(g + lane * 16 + 4 * j);
    for (int w0 = gw * 2; w0 < T; w0 += ngw * 2) {
        const int slv = __hip_atomic_load(tslot + 2 * (size_t)w0 + (lane & 3), __ATOMIC_RELAXED, __HIP_MEMORY_SCOPE_AGENT);
        const float cmv = __hip_atomic_load(tcomb + 2 * (size_t)w0 + (lane & 3), __ATOMIC_RELAXED, __HIP_MEMORY_SCOPE_AGENT);
        int sv[4]; f32x4 cm; size_t yrow[4];
#pragma unroll
        for (int q = 0; q < 4; ++q) { sv[q] = __builtin_amdgcn_readlane(slv, q); cm[q] = __builtin_bit_cast(float, __builtin_amdgcn_readlane(__builtin_bit_cast(int, cmv), q)) * (1.f / 16.f); }
#pragma unroll
        for (int q = 0; q < 4; ++q) yrow[q] = ((size_t)tst[sv[q] >> 16] * 256 + (sv[q] & 0xffff)) * 1024;
        u32x4 ra[2][2], rb[2], rc[2];
#pragma unroll
        for (int t = 0; t < 2; ++t) { const bf16_t* hr = h2 + (size_t)(w0 + t) * 1024 + lane * 16; ra[t][0] = *(const u32x4*)hr; ra[t][1] = *(const u32x4*)(hr + 8);
            rb[t] = *(const u32x4*)(Y + yrow[2 * t] + lane * 16); rc[t] = *(const u32x4*)(Y + yrow[2 * t + 1] + lane * 16); }
#pragma unroll
        for (int t = 0; t < 2; ++t) { float v[16]; float s = 0.f; const float c0 = cm[2 * t], c1 = cm[2 * t + 1];
#pragma unroll
            for (int q = 0; q < 4; ++q) { const f32x2 b0 = __builtin_amdgcn_cvt_pk_f32_fp8((int)rb[t][q], false), b1 = __builtin_amdgcn_cvt_pk_f32_fp8((int)rb[t][q], true);
                const f32x2 d0 = __builtin_amdgcn_cvt_pk_f32_fp8((int)rc[t][q], false), d1 = __builtin_amdgcn_cvt_pk_f32_fp8((int)rc[t][q], true);
                const unsigned h0 = ra[t][q >> 1][2 * (q & 1)], h1 = ra[t][q >> 1][2 * (q & 1) + 1];
                v[4 * q] = bflo(h0) + c0 * b0[0] + c1 * d0[0]; v[4 * q + 1] = bfhi(h0) + c0 * b0[1] + c1 * d0[1]; v[4 * q + 2] = bflo(h1) + c0 * b1[0] + c1 * d1[0]; v[4 * q + 3] = bfhi(h1) + c0 * b1[1] + c1 * d1[1]; }
#pragma unroll
            for (int q = 0; q < 16; ++q) s += v[q] * v[q];
            s = wave_sum(s); const float r = rsqrtf(s * (1.f / 1024.f) + EPS);
            float* orow = out + (size_t)(w0 + t) * 1024 + lane * 16;
#pragma unroll
            for (int j = 0; j < 4; ++j) *(f32x4*)(orow + 4 * j) = (f32x4){v[4 * j] * r * gg[j][0], v[4 * j + 1] * r * gg[j][1], v[4 * j + 2] * r * gg[j][2], v[4 * j + 3] * r * gg[j][3]}; }
    }
}

constexpr int LDS_BYTES = 147456;
__device__ __forceinline__ int vcu_of(int bx, int G) { return (G % 8 == 0) ? (bx % 8) * (G / 8) + bx / 8 : bx; }

enum { PH_P0 = 0, PH_INPROJ, PH_OUTPROJ, PH_KV, PH_FOLD, PH_S, PH_O, PH_GATEUP, PH_DOWN, PH_S1, PH_S2, PH_S3, PH_M1, PH_M5 };

template <int PH> __device__ __forceinline__ void run_phase(const Params& P, LAS unsigned char* lds, const int G, const int c, const int wv) {
    unsigned char* ws = P.ws;
    if constexpr (PH == PH_P0) { p0_prologue(P, lds, vcu_of(c, G), G, wv); }
    if constexpr (PH == PH_S1) { for (int ci = c; ci < 512; ci += G) s1_chunk(P, lds, ci, wv); }
    if constexpr (PH == PH_S2) { s2_scan(P, c, G, wv); }
    if constexpr (PH == PH_S3) { for (int ci = c; ci < 512; ci += G) s3_chunk(P, lds, ci, wv); }

    if constexpr (PH == PH_M5) { m5_final(P, lds, vcu_of(c, G), G * 8, wv); }
    if constexpr (PH == PH_INPROJ) {
        pg8::PlainSched S; S.lda = 1024; S.A = (const char*)(ws + WS_A); S.B = (const char*)(ws + WS_WIN); S.C = (char*)(ws + WS_PROJ); S.ldb = 1024; S.ldc = NPROJ; S.esz = 2; S.nM = T / 256; S.nN = NPROJ / 256; S.G = G; S.c = c; S.bper = 0; S.bstride = 0;
        EpiRowScale E{(const float*)(ws + WS_RSTDX), NPROJ};
        if (PROBE_DUP == 41) { S.kdup = 2; E.mul = 0.5f; }
        if (PROBE_DUP == 40) S.edup = 1;
        pg8::gemm_phase(lds, 1024, S, E, wv);
    }
    if constexpr (PH == PH_OUTPROJ) {
        pg8::PlainSched S; S.lda = 1024; S.A = (const char*)(ws + WS_YCAT); S.B = (const char*)(ws + WS_WOUT); S.C = (char*)(ws + WS_H1); S.ldb = 1024; S.ldc = 1024; S.esz = 2; S.nM = T / 256; S.nN = 4; S.G = G; S.c = c; S.bper = 0; S.bstride = 0;
        EpiResid E{(const bf16_t*)(ws + WS_A), (float*)(ws + WS_SSQ1), ATT_S_F8 ? (unsigned char*)(ws + WS_H2F8) : nullptr};
        pg8::gemm_phase(lds, 1024, S, E, wv);
    }
    if constexpr (PH == PH_KV) {
        pg8::PlainSched S; S.lda = 1024; S.A = (const char*)(ws + WS_MEMB); S.B = (const char*)(ws + WS_WKV); S.C = (char*)(ws + WS_KV); S.ldb = 1024; S.ldc = 2048; S.esz = 2; S.nM = NMEM / 256; S.nN = 8; S.G = G; S.c = c; S.bper = 0; S.bstride = 0;
        EpiRowScale E{(const float*)(ws + WS_RSTDM), 2048};
        pg8::gemm_phase(lds, 1024, S, E, wv);
    }
    if constexpr (PH == PH_FOLD) {
        EpiRowScale E{nullptr, 1024};
        if (ATT_O_F8 && c >= 128) { E.f8out = true; E.mul = 8.f; }
        if (ATT_S_F8 && c < 128) { E.f8out = true; E.mul = 16.f; }
        FoldSched S; const bool m0 = c < 128; S.lda = m0 ? 2048 : 1024; S.ldb = m0 ? 1024 : 2048; S.kv = (const char*)(ws + WS_KV); S.wq = (const char*)(ws + WS_WQP); S.wo = (const char*)(ws + WS_WO);
        S.mt = (char*)(ws + WS_MT); S.nt = (char*)(ws + WS_NT); S.G = G; S.c = c;
        pg8::gemm_phase(lds, 256, S, E, wv);
    }
    if constexpr (PH == PH_S) {
        EpiSoftmax E{(const float*)(ws + WS_SSQ1)};
        if constexpr (ATT_S_F8) {
            pg8::PlainSched8<123, 127> S; S.lda = 1024; S.A = (const char*)(ws + WS_H2F8); S.B = (const char*)(ws + WS_MT); S.C = (char*)(ws + WS_A); S.ldb = 1024; S.ldc = 1024; S.esz = ATT_O_F8 ? 1 : 2; S.nM = T / 256; S.nN = 4; S.G = G; S.c = c; S.bper = 32; S.bstride = (size_t)1024 * 1024;
            pg8::gemm_phase(lds, 1024, S, E, wv);
        } else {
            pg8::PlainSched S; S.lda = 1024; S.A = (const char*)(ws + WS_H1); S.B = (const char*)(ws + WS_MT); S.C = (char*)(ws + WS_A); S.ldb = 1024; S.ldc = 1024; S.esz = ATT_O_F8 ? 1 : 2; S.nM = T / 256; S.nN = 4; S.G = G; S.c = c; S.bper = 32; S.bstride = (size_t)1024 * 1024 * 2;
            pg8::gemm_phase(lds, 1024, S, E, wv);
        }
    }
    if constexpr (PH == PH_O) {
        EpiResid E{(const bf16_t*)(ws + WS_H1), (float*)(ws + WS_SSQ2), MOE_GU_F8 ? (unsigned char*)(ws + WS_H2F8) : nullptr};
        if constexpr (ATT_O_F8) {
            pg8::PlainSched8<124, 119> S; S.lda = 1024; S.A = (const char*)(ws + WS_A); S.B = (const char*)(ws + WS_NT); S.C = (char*)(ws + WS_H2); S.ldb = 1024; S.ldc = 1024; S.esz = 2; S.nM = T / 256; S.nN = 4; S.G = G; S.c = c; S.bper = 32; S.bstride = (size_t)1024 * 1024;
            pg8::gemm_phase(lds, 1024, S, E, wv);
        } else {
            pg8::PlainSched S; S.lda = 1024; S.A = (const char*)(ws + WS_A); S.B = (const char*)(ws + WS_NT); S.C = (char*)(ws + WS_H2); S.ldb = 1024; S.ldc = 1024; S.esz = 2; S.nM = T / 256; S.nN = 4; S.G = G; S.c = c; S.bper = 32; S.bstride = (size_t)1024 * 1024 * 2;
            pg8::gemm_phase(lds, 1024, S, E, wv);
        }
    }
    if constexpr (PH == PH_GATEUP) {
        moe_build_table(lds, (const unsigned*)(ws + WS_CTL), wv);
        GateUpSched S; S.hb = (const char*)(ws + (MOE_GU_F8 ? WS_H2F8 : WS_H2)); S.wgu = (const char*)(ws + WS_WGU); S.hbuf = (char*)(ws + WS_HBUF); S.lsrc = (const int*)(ws + WS_LSRC); S.tb.t = (const LAS int*)(lds + pg8::STAGE_BYTES + 4096); S.ldb = 1024; S.G = G; S.c = c;
        EpiSwiGLU E{(const float*)(ws + WS_LRS)};
        pg8::gemm_phase(lds, 1024, S, E, wv);
    }
    if constexpr (PH == PH_DOWN) {
        moe_build_table(lds, (const unsigned*)(ws + WS_CTL), wv);
        DownSched S; S.lda = DEXP; S.hbuf = (const char*)(ws + WS_HBUF); S.wd = (const char*)(ws + WS_WD); S.ysort = (char*)(ws + WS_Y); S.tb.t = (const LAS int*)(lds + pg8::STAGE_BYTES + 4096); S.ldb = DEXP; S.G = G; S.c = c;
        EpiRowScale E{nullptr, 1024}; E.f8out = true; E.mul = 16.f;
        pg8::gemm_phase(lds, DEXP, S, E, wv);
    }
}
constexpr int CW_BAR = 4096;
#if !defined(MULTI_LAUNCH)
__global__ void __launch_bounds__(512, 2) k_mega(Params P) {
    extern __shared__ __attribute__((aligned(16))) unsigned char lds_raw[];
    LAS unsigned char* lds = (LAS unsigned char*)lds_raw;
    const int G = gridDim.x, c = blockIdx.x, wv = __builtin_amdgcn_readfirstlane(threadIdx.x >> 6);
    if (tid_from(wv) == 0) *(LAS u32x4*)(lds + LDS_BYTES - 16) = (u32x4){0u, 0u, 0u, 0u};
    __syncthreads();
    const XcdBarrier bar = xcd_barrier_post((unsigned*)(P.ws + WS_CTL) + CW_BAR, (volatile LAS unsigned*)(lds + LDS_BYTES - 16), tid_from(wv) == 0);
#define PH_RUN(id, ...) do { __VA_ARGS__; if (PROBE_DUP == (id)) { xcd_barrier(bar, tid_from(wv) == 0); __VA_ARGS__; } } while (0)
    PH_RUN(0, run_phase<PH_P0>(P, lds, G, c, wv));      xcd_barrier(bar, tid_from(wv) == 0);
    PH_RUN(1, run_phase<PH_INPROJ>(P, lds, G, c, wv));  xcd_barrier(bar, tid_from(wv) == 0);
    PH_RUN(2, run_phase<PH_S1>(P, lds, G, c, wv));      xcd_barrier(bar, tid_from(wv) == 0);
    PH_RUN(3, if (c < 64) run_phase<PH_KV>(P, lds, 64, c, wv); else s2_scan(P, c - 64, G - 64, wv));
    xcd_barrier(bar, tid_from(wv) == 0);
    PH_RUN(4, run_phase<PH_FOLD>(P, lds, G, c, wv); run_phase<PH_S3>(P, lds, G, c, wv));      xcd_barrier(bar, tid_from(wv) == 0);
    PH_RUN(5, run_phase<PH_OUTPROJ>(P, lds, G, c, wv)); xcd_barrier(bar, tid_from(wv) == 0);
    PH_RUN(6, run_phase<PH_S>(P, lds, G, c, wv));       xcd_barrier(bar, tid_from(wv) == 0);
    PH_RUN(7, run_phase<PH_O>(P, lds, G, c, wv));       xcd_barrier(bar, tid_from(wv) == 0);
    m1_router(P, lds, c, G, wv, bar);    xcd_barrier(bar, tid_from(wv) == 0);
    PH_RUN(9, run_phase<PH_GATEUP>(P, lds, G, c, wv));  xcd_barrier(bar, tid_from(wv) == 0);
    PH_RUN(10, run_phase<PH_DOWN>(P, lds, G, c, wv));    xcd_barrier(bar, tid_from(wv) == 0);
    PH_RUN(11, run_phase<PH_M5>(P, lds, G, c, wv));
    if (PROBE_DUP == 12) { for (int i = 0; i < 8; ++i) xcd_barrier(bar, tid_from(wv) == 0); }
    if (PROBE_DUP == 20) { xcd_barrier(bar, tid_from(wv) == 0); p0_prologue(P, lds, vcu_of(c, G), G, wv, 1); }
    if (PROBE_DUP == 21) { xcd_barrier(bar, tid_from(wv) == 0); p0_prologue(P, lds, vcu_of(c, G), G, wv, 2); }
#undef PH_RUN
}
#else
template <int PH> __global__ void __launch_bounds__(512, 2) k_phase(Params P) {
    extern __shared__ __attribute__((aligned(16))) unsigned char lds_raw[];
    run_phase<PH>(P, (LAS unsigned char*)lds_raw, gridDim.x, blockIdx.x, __builtin_amdgcn_readfirstlane(threadIdx.x >> 6));
}
#endif

#if defined(MULTI_LAUNCH)
template <int PH> static void launch_phase(const Params& P, int grid, hipStream_t stream) {
    static bool attr = false;
    if (!attr) { (void)hipFuncSetAttribute((const void*)k_phase<PH>, hipFuncAttributeMaxDynamicSharedMemorySize, LDS_BYTES); attr = true; }
    hipLaunchKernelGGL(k_phase<PH>, dim3(grid), dim3(512), LDS_BYTES, stream, P);
}
#endif
extern "C" void kernel_launch(void* const* d_in, const int* in_sizes, int n_in, void* d_out, int out_size, void* d_ws, size_t ws_size, hipStream_t stream) {
    if (n_in != 26 || out_size != T * D || ws_size < WS_END) { fprintf(stderr, "kernel_launch: unexpected shapes (n_in %d out %d ws %zu)\n", n_in, out_size, ws_size); return; }
    const int grid = 256;
    Params P{};
    for (int i = 0; i < 26; ++i) P.in[i] = (const float*)d_in[i];
    P.out = (float*)d_out; P.ws = (unsigned char*)d_ws;
    (void)hipMemsetAsync(P.ws + WS_CTL, 0, CTL_BYTES, stream);
#if !defined(MULTI_LAUNCH)
    static bool attr = false;
    if (!attr) { (void)hipFuncSetAttribute((const void*)k_mega, hipFuncAttributeMaxDynamicSharedMemorySize, LDS_BYTES); attr = true; }
    hipLaunchKernelGGL(k_mega, dim3(grid), dim3(512), LDS_BYTES, stream, P);
#else
    launch_phase<PH_P0>(P, grid, stream);
    launch_phase<PH_INPROJ>(P, grid, stream);
    launch_phase<PH_S1>(P, grid, stream);
    launch_phase<PH_S2>(P, grid, stream);
    launch_phase<PH_KV>(P, grid, stream);
    launch_phase<PH_FOLD>(P, grid, stream);
    launch_phase<PH_S3>(P, grid, stream);
    launch_phase<PH_OUTPROJ>(P, grid, stream);
    launch_phase<PH_S>(P, grid, stream);
    launch_phase<PH_O>(P, grid, stream);
    launch_phase<PH_GATEUP>(P, grid, stream);
    launch_phase<PH_DOWN>(P, grid, stream);
    launch_phase<PH_M5>(P, grid, stream);
#endif
}
```
